# Optimizing an MI355X kernel written in HIP

```python
import math
import jax, jax.numpy as jnp
from jax import lax
import numpy as np

D_MODEL = 1024
BATCH = 8
SEQ = 4096
DEPTH = 2

GRID_W = 64
CTX_LEN = 256
N_HEADS = 8
Q_LORA = 256
KV_LORA = 128
QK_NOPE = 64
QK_ROPE = 32
V_HEAD = 64
ATT_WIDTH = N_HEADS * V_HEAD
ATT_SCALE = (QK_NOPE + QK_ROPE) ** -0.5
ROPE_BASE = 10000.0
Q_BLOCK = 128
FOURIER_WIDTH = 256
POOL_WINDOWS = (2, 4, 8, 16)
POOL_GROUP = 64
POOL_WIDTH = POOL_GROUP * len(POOL_WINDOWS)
N_BRANCH = 3
IN_WIDTH = Q_LORA + KV_LORA + QK_ROPE + FOURIER_WIDTH + POOL_WIDTH + N_BRANCH * D_MODEL
SPLITS = (Q_LORA, Q_LORA + KV_LORA, Q_LORA + KV_LORA + QK_ROPE,
          Q_LORA + KV_LORA + QK_ROPE + FOURIER_WIDTH,
          Q_LORA + KV_LORA + QK_ROPE + FOURIER_WIDTH + POOL_WIDTH)
PEER_HEADS = 8
N_KEYS = 128
N_EXPERTS = N_KEYS * N_KEYS
PEER_QDIM = 256
PEER_TOPK = 16
TOKEN_BLOCK = 128
EPS = 1e-6

kernel_name = "hybrid_mla_fnet_pool_peer_dit"


def _rmsnorm(x, g):
    xf = x.astype(jnp.float32)
    y = xf * lax.rsqrt(jnp.mean(xf * xf, axis=-1, keepdims=True) + EPS)
    return (y * g.astype(jnp.float32)).astype(x.dtype)


def _modulation(cvec, w_mod, b_mod):
    m = jax.nn.silu(cvec) @ w_mod + b_mod
    return jnp.split(m[:, None, :], 6, axis=-1)


def _modulate(x, g, shift, scale):
    return _rmsnorm(x, g) * (1 + scale) + shift


def _axial_angles(L):
    rows = L // GRID_W
    r, cl = jnp.meshgrid(jnp.arange(rows, dtype=jnp.float32),
                         jnp.arange(GRID_W, dtype=jnp.float32), indexing="ij")
    half = QK_ROPE // 2
    inv_freq = ROPE_BASE ** (-jnp.arange(0, half, 2, dtype=jnp.float32) / half)
    ang_r = r.reshape(L, 1, 1) * inv_freq
    ang_c = cl.reshape(L, 1, 1) * inv_freq
    return ang_r, ang_c


def _rotate_half(x, ang):
    x1, x2 = jnp.split(x.astype(jnp.float32), 2, axis=-1)
    cos, sin = jnp.cos(ang), jnp.sin(ang)
    return jnp.concatenate([x1 * cos - x2 * sin, x1 * sin + x2 * cos], axis=-1)


def _rope_2d(x, ang):
    ang_r, ang_c = ang
    xr, xc = jnp.split(x, 2, axis=-1)
    return jnp.concatenate([_rotate_half(xr, ang_r), _rotate_half(xc, ang_c)], axis=-1).astype(x.dtype)


def _mla_q(cq, lp, ang):
    B, L, _ = cq.shape
    q = (_rmsnorm(cq, lp["q_norm_g"]) @ lp["w_uq"]).reshape(B, L, N_HEADS, QK_NOPE + QK_ROPE)
    q_nope, q_rope = q[..., :QK_NOPE], q[..., QK_NOPE:]
    if ang is not None:
        q_rope = _rope_2d(q_rope, ang)
    return jnp.concatenate([q_nope, q_rope], axis=-1)


def _mla_kv(ckv, kr, lp, ang):
    B, L, _ = ckv.shape
    kv = (_rmsnorm(ckv, lp["kv_norm_g"]) @ lp["w_ukv"]).reshape(B, L, N_HEADS, QK_NOPE + V_HEAD)
    k_nope, v = kv[..., :QK_NOPE], kv[..., QK_NOPE:]
    k_rope = kr[:, :, None, :]
    if ang is not None:
        k_rope = _rope_2d(k_rope, ang)
    k = jnp.concatenate([k_nope, jnp.broadcast_to(k_rope, (B, L, N_HEADS, QK_ROPE))], axis=-1)
    return k, v


def _attend(q, k, v):
    s = jnp.einsum("bqhd,bkhd->bhqk", q, k, preferred_element_type=jnp.float32) * ATT_SCALE
    p = jax.nn.softmax(s, axis=-1).astype(v.dtype)
    return jnp.einsum("bhqk,bkhd->bqhd", p, v)


def _latent_attention(q, k, v, kv_ctx):
    k_ctx, v_ctx = kv_ctx
    k_all = jnp.concatenate([k_ctx, k], axis=1)
    v_all = jnp.concatenate([v_ctx, v], axis=1)
    B, L, H, Dq = q.shape
    nb = L // Q_BLOCK
    qb = jnp.moveaxis(q.reshape(B, nb, Q_BLOCK, H, Dq), 1, 0)
    o = lax.map(lambda qq: _attend(qq, k_all, v_all), qb)
    return jnp.moveaxis(o, 0, 1).reshape(B, L, ATT_WIDTH)


def _fourier_mix(z):
    zf = z.astype(jnp.float32)
    return jnp.real(jnp.fft.fft2(zf, axes=(1, 2), norm="ortho")).astype(z.dtype)


def _pool_mix(z, w_grp, pool_scale):
    B, L, _ = z.shape
    zf = z.astype(jnp.float32)
    cs = jnp.concatenate([jnp.zeros((B, 1, POOL_WIDTH), jnp.float32), jnp.cumsum(zf, axis=1)], axis=1)
    t = jnp.arange(L)
    outs = []
    for gi, w in enumerate(POOL_WINDOWS):
        lo = jnp.clip(t - w // 2, 0, L)
        hi = jnp.clip(t - w // 2 + w, 0, L)
        seg = cs[:, :, gi * POOL_GROUP:(gi + 1) * POOL_GROUP]
        cnt = (hi - lo).astype(jnp.float32)[None, :, None]
        outs.append((seg[:, hi] - seg[:, lo]) / cnt - zf[:, :, gi * POOL_GROUP:(gi + 1) * POOL_GROUP])
    pooled = jnp.concatenate(outs, axis=-1).astype(z.dtype).reshape(B, L, len(POOL_WINDOWS), POOL_GROUP)
    y = jnp.einsum("blgc,gcd->blgd", pooled, w_grp).reshape(B, L, POOL_WIDTH)
    return y * pool_scale


def _token_mix(h, lp, ang, kv_ctx):
    B, L, _ = h.shape
    z = h @ lp["w_in"]
    cq, ckv, kr, zf, zp, zg = jnp.split(z, SPLITS, axis=-1)
    q = _mla_q(cq, lp, ang)
    k, v = _mla_kv(ckv, kr, lp, ang)
    if kv_ctx is None:
        att = _attend(q, k, v).reshape(B, L, ATT_WIDTH)
    else:
        att = _latent_attention(q, k, v, kv_ctx)
    y_a = att @ lp["w_oa"]
    y_b = _fourier_mix(zf) @ lp["w_ob"]
    y_c = _pool_mix(zp, lp["w_grp"], lp["pool_scale"]) @ lp["w_oc"]
    g = jax.nn.sigmoid((zg + lp["b_gate"]).astype(jnp.float32)).astype(h.dtype)
    g_a, g_b, g_c = jnp.split(g, N_BRANCH, axis=-1)
    return (g_a * y_a + g_b * y_b + g_c * y_c) @ lp["w_out"], (k, v)


def _ctx_keys_values(hc, lp):
    z = hc @ lp["w_in"][:, Q_LORA:Q_LORA + KV_LORA + QK_ROPE]
    ckv, kr = z[..., :KV_LORA], z[..., KV_LORA:]
    return _mla_kv(ckv, kr, lp, None)


def _peer(h, w_pq, peer_keys, peer_down, peer_up):
    B, L, D = h.shape
    q = (h @ w_pq).reshape(B, L, PEER_HEADS, 2, PEER_QDIM // 2)
    s = jnp.einsum("blhpd,hpkd->blhpk", q, peer_keys, preferred_element_type=jnp.float32)
    sv, si = lax.top_k(s, PEER_TOPK)
    cand = (sv[..., 0, :, None] + sv[..., 1, None, :]).reshape(B, L, PEER_HEADS, PEER_TOPK * PEER_TOPK)
    cidx = (si[..., 0, :, None] * N_KEYS + si[..., 1, None, :]).reshape(B, L, PEER_HEADS, PEER_TOPK * PEER_TOPK)
    top_s, pos = lax.top_k(cand, PEER_TOPK)
    eidx = jnp.take_along_axis(cidx, pos, axis=-1)
    gate = jax.nn.softmax(top_s, axis=-1)
    T = B * L
    nb = T // TOKEN_BLOCK
    hb = h.reshape(nb, TOKEN_BLOCK, D)
    eb = eidx.reshape(nb, TOKEN_BLOCK, PEER_HEADS * PEER_TOPK)
    gb = gate.reshape(nb, TOKEN_BLOCK, PEER_HEADS * PEER_TOPK)

    def one(args):
        hh, ee, gg = args
        a = jnp.einsum("tkd,td->tk", peer_down[ee], hh, preferred_element_type=jnp.float32)
        act = (gg * jax.nn.gelu(a)).astype(hh.dtype)
        return jnp.einsum("tk,tkd->td", act, peer_up[ee])

    return lax.map(one, (hb, eb, gb)).reshape(B, L, D)


def setup_inputs(seed: int = 0) -> dict:
    key = jax.random.key(seed)
    ks = jax.random.split(key, 25)
    D = D_MODEL

    def n(k, shape, s):
        return jax.random.normal(k, shape, jnp.float32) * s

    return {
        "x": n(ks[0], (BATCH, SEQ, D), 1.0),
        "c": n(ks[1], (BATCH, D), 1.0),
        "ctx": n(ks[2], (BATCH, CTX_LEN, D), 1.0),
        "c_ctx": n(ks[3], (D,), 1.0),
        "w_mod": n(ks[4], (DEPTH, D, 6 * D), 0.5 * D ** -0.5),
        "b_mod": n(ks[5], (DEPTH, 6 * D), 0.01),
        "norm1_g": 1.0 + n(ks[6], (DEPTH, D), 0.02),
        "norm2_g": 1.0 + n(ks[7], (DEPTH, D), 0.02),
        "w_in": n(ks[8], (DEPTH, D, IN_WIDTH), D ** -0.5),
        "b_gate": n(ks[9], (DEPTH, N_BRANCH * D), 0.01),
        "q_norm_g": 1.0 + n(ks[10], (DEPTH, Q_LORA), 0.02),
        "w_uq": n(ks[11], (DEPTH, Q_LORA, N_HEADS * (QK_NOPE + QK_ROPE)), Q_LORA ** -0.5),
        "kv_norm_g": 1.0 + n(ks[12], (DEPTH, KV_LORA), 0.02),
        "w_ukv": n(ks[13], (DEPTH, KV_LORA, N_HEADS * (QK_NOPE + V_HEAD)), KV_LORA ** -0.5),
        "w_oa": n(ks[14], (DEPTH, ATT_WIDTH, D), ATT_WIDTH ** -0.5),
        "w_ob": n(ks[15], (DEPTH, FOURIER_WIDTH, D), FOURIER_WIDTH ** -0.5),
        "w_grp": n(ks[16], (DEPTH, len(POOL_WINDOWS), POOL_GROUP, POOL_GROUP), POOL_GROUP ** -0.5),
        "pool_scale": 1.0 + n(ks[17], (DEPTH, POOL_WIDTH), 0.02),
        "w_oc": n(ks[18], (DEPTH, POOL_WIDTH, D), POOL_WIDTH ** -0.5),
        "w_out": n(ks[19], (DEPTH, D, D), D ** -0.5),
        "w_pq": n(ks[20], (DEPTH, D, PEER_HEADS * PEER_QDIM), D ** -0.5),
        "peer_keys": n(ks[21], (DEPTH, PEER_HEADS, 2, N_KEYS, PEER_QDIM // 2), (PEER_QDIM // 2) ** -0.5),
        "peer_down": n(ks[22], (DEPTH, N_EXPERTS, D), D ** -0.5),
        "peer_up": n(ks[23], (DEPTH, N_EXPERTS, D), PEER_HEADS ** -0.5),
        "final_g": 1.0 + n(ks[24], (D,), 0.02),
    }


def reference(x, c, ctx, c_ctx, w_mod, b_mod, norm1_g, norm2_g, w_in, b_gate, q_norm_g, w_uq,
              kv_norm_g, w_ukv, w_oa, w_ob, w_grp, pool_scale, w_oc, w_out, w_pq, peer_keys,
              peer_down, peer_up, final_g):
    L = x.shape[1]
    ang = _axial_angles(L)
    for l in range(DEPTH):
        last = l == DEPTH - 1
        lp = {"w_in": w_in[l], "b_gate": b_gate[l], "q_norm_g": q_norm_g[l], "w_uq": w_uq[l],
              "kv_norm_g": kv_norm_g[l], "w_ukv": w_ukv[l], "w_oa": w_oa[l], "w_ob": w_ob[l],
              "w_grp": w_grp[l], "pool_scale": pool_scale[l], "w_oc": w_oc[l], "w_out": w_out[l]}
        m_x = _modulation(c, w_mod[l], b_mod[l])
        m_c = _modulation(c_ctx[None, :], w_mod[l], b_mod[l])
        h = _modulate(x, norm1_g[l], m_x[0], m_x[1])
        hc = _modulate(ctx, norm1_g[l], m_c[0], m_c[1])
        if last:
            kv_c = _ctx_keys_values(hc, lp)
        else:
            mix_c, kv_c = _token_mix(hc, lp, None, None)
        mix_x, _ = _token_mix(h, lp, ang, kv_c)
        x = x + m_x[2] * mix_x
        h2 = _modulate(x, norm2_g[l], m_x[3], m_x[4])
        x = x + m_x[5] * _peer(h2, w_pq[l], peer_keys[l], peer_down[l], peer_up[l])
        if not last:
            ctx = ctx + m_c[2] * mix_c
            hc2 = _modulate(ctx, norm2_g[l], m_c[3], m_c[4])
            ctx = ctx + m_c[5] * _peer(hc2, w_pq[l], peer_keys[l], peer_down[l], peer_up[l])
    return _rmsnorm(x, final_g)
```

```cpp
#include <hip/hip_runtime.h>
#include <hip/hip_cooperative_groups.h>
#include <cstdio>
#include <cstdint>
namespace cg = cooperative_groups;

typedef unsigned short bf16_t;
typedef __attribute__((ext_vector_type(8))) short bf16x8;
typedef __attribute__((ext_vector_type(4))) float f32x4;
typedef __attribute__((ext_vector_type(2))) __bf16 bf2_t;
typedef __attribute__((ext_vector_type(2))) float f32x2;

#define DEV __device__ __forceinline__
DEV int tidx() { int v = threadIdx.x; asm volatile("" : "+v"(v)); return v; }
DEV int bidx() { int v = blockIdx.x; asm volatile("" : "+s"(v)); return v; }
DEV int gdim() { int v = gridDim.x; asm volatile("" : "+s"(v)); return v; }

constexpr int NTOK = 34816;
constexpr int NXTOK = 32768;
constexpr int NKEY = 4352;
constexpr int SMEM_BYTES = 131072;
constexpr int NTHR = 512, NWAVE = 8;
#define LAS __attribute__((address_space(3)))

struct Params {
  const float *x, *c, *ctx, *c_ctx, *w_mod, *b_mod, *norm1_g, *norm2_g, *w_in, *b_gate, *q_norm_g, *w_uq,
      *kv_norm_g, *w_ukv, *w_oa, *w_ob, *w_grp, *pool_scale, *w_oc, *w_out, *w_pq, *peer_keys, *peer_down,
      *peer_up, *final_g;
  float* out;
  float* Xc;
  bf16_t *H, *S1, *UTx, *UTc, *POOLED, *R2;
  bf16_t *WinT, *WuqT, *WukvT, *WoaT, *WobT, *WpcT, *WoutT, *WpqT, *KEYS, *A2, *A2c, *CS;
  float* MOD;
  unsigned char *PD8, *PU8;
  float *SD, *SU;
  unsigned* BAR;
  float* ROPE;
};

DEV bf16_t f2bf(float f) {
  unsigned u = __float_as_uint(f);
  u += 0x7fffu + ((u >> 16) & 1u);
  return (bf16_t)(u >> 16);
}
DEV float bf2f(bf16_t h) { return __uint_as_float(((unsigned)h) << 16); }
DEV unsigned pack2(float a, float b) { unsigned r; asm("v_cvt_pk_bf16_f32 %0, %1, %2" : "=v"(r) : "v"(a), "v"(b)); return r; }
DEV float bflo(unsigned u) { return __uint_as_float(u << 16); }
DEV float bfhi(unsigned u) { return __uint_as_float(u & 0xffff0000u); }
template <int CTRL, int RMASK>
DEV float dpp_f(float v) {
  return __builtin_bit_cast(float, __builtin_amdgcn_update_dpp(0, __builtin_bit_cast(int, v), CTRL, RMASK, 0xF, false));
}
DEV float wave_sum(float v) {
  v += dpp_f<0xB1, 0xF>(v);
  v += dpp_f<0x4E, 0xF>(v);
  v += dpp_f<0x141, 0xF>(v);
  v += dpp_f<0x140, 0xF>(v);
  v += dpp_f<0x142, 0xA>(v);
  v += dpp_f<0x143, 0xC>(v);
  return __builtin_bit_cast(float, __builtin_amdgcn_readlane(__builtin_bit_cast(int, v), 63));
}
DEV unsigned wave_max_u(unsigned v) {
#pragma unroll
  for (int o = 32; o > 0; o >>= 1) {
    unsigned w = (unsigned)__shfl_xor((int)v, o);
    v = v > w ? v : w;
  }
  return v;
}
DEV float xmax16(float v) { auto r = __builtin_amdgcn_permlane16_swap(__builtin_bit_cast(unsigned, v), __builtin_bit_cast(unsigned, v), false, false);
  return fmaxf(__builtin_bit_cast(float, r[0]), __builtin_bit_cast(float, r[1])); }
DEV float xmax32(float v) { auto r = __builtin_amdgcn_permlane32_swap(__builtin_bit_cast(unsigned, v), __builtin_bit_cast(unsigned, v), false, false);
  return fmaxf(__builtin_bit_cast(float, r[0]), __builtin_bit_cast(float, r[1])); }
DEV float xsum16(float v) { auto r = __builtin_amdgcn_permlane16_swap(__builtin_bit_cast(unsigned, v), __builtin_bit_cast(unsigned, v), false, false);
  return __builtin_bit_cast(float, r[0]) + __builtin_bit_cast(float, r[1]); }
DEV float xsum32(float v) { auto r = __builtin_amdgcn_permlane32_swap(__builtin_bit_cast(unsigned, v), __builtin_bit_cast(unsigned, v), false, false);
  return __builtin_bit_cast(float, r[0]) + __builtin_bit_cast(float, r[1]); }
DEV float wave_max_f(float v) {
  v = fmaxf(v, dpp_f<0xB1, 0xF>(v)); v = fmaxf(v, dpp_f<0x4E, 0xF>(v));
  v = fmaxf(v, dpp_f<0x141, 0xF>(v)); v = fmaxf(v, dpp_f<0x140, 0xF>(v));
  v = xmax16(v); v = xmax32(v); return v; }
DEV unsigned xmaxu16(unsigned v) { auto r = __builtin_amdgcn_permlane16_swap(v, v, false, false); return r[0] > r[1] ? r[0] : r[1]; }
DEV unsigned xmaxu32(unsigned v) { auto r = __builtin_amdgcn_permlane32_swap(v, v, false, false); return r[0] > r[1] ? r[0] : r[1]; }
DEV int xcd_remap(int c, int G) { return (c & 7) * (G >> 3) + (c >> 3); }
DEV unsigned orderable(float f) {
  unsigned u = __float_as_uint(f);
  return (u & 0x80000000u) ? ~u : (u | 0x80000000u);
}
DEV float unorderable(unsigned u) {
  return __uint_as_float((u & 0x80000000u) ? (u ^ 0x80000000u) : ~u);
}
DEV float* sv_ptr(const Params& p) { return reinterpret_cast<float*>(reinterpret_cast<char*>(p.R2) + ((size_t)64 << 20)); }
DEV unsigned char* si_ptr(const Params& p) { return reinterpret_cast<unsigned char*>(sv_ptr(p) + (size_t)NTOK * 256); }
DEV float* xrow(const Params& p, int t) {
  return t < NXTOK ? p.out + (size_t)t * 1024 : p.Xc + (size_t)(t - NXTOK) * 1024;
}
DEV bf16x8 mk8(uint2 lo, uint2 hi) {
  uint4 v = make_uint4(lo.x, lo.y, hi.x, hi.y);
  return __builtin_bit_cast(bf16x8, v);
}
DEV bf16x8 pack8(const f32x4& a, const f32x4& b) {
  uint4 v = make_uint4(pack2(a[0], a[1]), pack2(a[2], a[3]), pack2(b[0], b[1]), pack2(b[2], b[3]));
  return __builtin_bit_cast(bf16x8, v);
}


#define XB_TMO      128
#define XB_XCNT(j)  (256  + 64 * (j))
#define XB_XSUB(j)  (1280 + 64 * (j))
#define XB_XGEN(j)  (2304 + 64 * (j))
#define XB_TOP      3328
#define XB_TOPGEN   3392
#define XCD_BAR_WORDS 3456
#define XB_SPIN_CAP (1u << 20)
DEV unsigned xb_ld(unsigned* p) { return __hip_atomic_load(p, __ATOMIC_RELAXED, __HIP_MEMORY_SCOPE_AGENT); }
DEV unsigned xb_add(unsigned* p, unsigned v) { return __hip_atomic_fetch_add(p, v, __ATOMIC_RELAXED, __HIP_MEMORY_SCOPE_AGENT); }
DEV unsigned xb_xcc_id() { return (unsigned)__builtin_amdgcn_s_getreg((3 << 11) | 20) & 0xFu; }
#define XB_SPIN(cond, bar) do { unsigned _sp = 0; while (cond) { __builtin_amdgcn_s_sleep(1); \
    if ((++_sp & 255u) == 0u) { if (xb_ld(&(bar)[XB_TMO])) break; if (_sp > XB_SPIN_CAP) { atomicAdd(&(bar)[XB_TMO], 1u); break; } } } } while (0)

struct XcdBarrier { unsigned* bar; unsigned x; volatile unsigned* st; };

DEV XcdBarrier xcd_barrier_post(unsigned* bar, volatile unsigned* st) {
  XcdBarrier b; b.bar = bar; b.x = xb_xcc_id(); b.st = st;
  if (threadIdx.x == 0) (void)xb_add(&bar[XB_XCNT(b.x)], 1u);
  return b;
}
DEV void xcd_barrier_complete(unsigned* bar, unsigned x, unsigned& nloc, unsigned& nx) {
  const unsigned G = gridDim.x;
  unsigned sum, cnt, mine, sp = 0u;
  for (;;) {
    sum = 0u; cnt = 0u; mine = 0u;
#pragma unroll
    for (unsigned j = 0; j < 16; ++j) { const unsigned c = xb_ld(&bar[XB_XCNT(j)]); sum += c; cnt += (c > 0u) ? 1u : 0u; mine = (j == x) ? c : mine; }
    if (sum == G) break;
    __builtin_amdgcn_s_sleep(1);
    if ((++sp & 255u) == 0u) { if (xb_ld(&bar[XB_TMO])) break; if (sp > XB_SPIN_CAP) { atomicAdd(&bar[XB_TMO], 1u); break; } }
  }
  nloc = mine > 0u ? mine : 1u; nx = cnt > 0u ? cnt : 1u;
}
DEV void xcd_barrier(const XcdBarrier& b) {
  asm volatile("s_waitcnt vmcnt(0)" ::: "memory");
  __syncthreads();
  if (threadIdx.x == 0) {
    unsigned* bar = b.bar;
    __builtin_amdgcn_s_waitcnt(0);
    unsigned nloc = b.st[0], nx = b.st[1];
    if (nloc == 0u) { xcd_barrier_complete(bar, b.x, nloc, nx); b.st[0] = nloc; b.st[1] = nx; }
    const unsigned old = xb_add(&bar[XB_XSUB(b.x)], 1u);
    const unsigned gen = old / nloc;
    if (old + 1u == (gen + 1u) * nloc) {
      __builtin_amdgcn_fence(__ATOMIC_RELEASE, "agent");
      asm volatile("s_waitcnt vmcnt(0)" ::: "memory");
      const unsigned og = xb_add(&bar[XB_TOP], 1u);
      const unsigned tg = og / nx;
      if (og + 1u == (tg + 1u) * nx) xb_add(&bar[XB_TOPGEN], 1u);
      else XB_SPIN(xb_ld(&bar[XB_TOPGEN]) == tg, bar);
      __builtin_amdgcn_fence(__ATOMIC_ACQUIRE, "agent");
      xb_add(&bar[XB_XGEN(b.x)], 1u);
      asm volatile("s_waitcnt vmcnt(0)" ::: "memory");
    } else {
      XB_SPIN(xb_ld(&bar[XB_XGEN(b.x)]) == gen, bar);
      __builtin_amdgcn_fence(__ATOMIC_ACQUIRE, "agent");
      asm volatile("s_waitcnt vmcnt(0)" ::: "memory");
    }
  }
  __syncthreads();
}

template <int WM, int WN>
DEV void gemm_mainloop(const bf16_t* __restrict__ A, long lda, const bf16_t* __restrict__ B, long ldb, int K,
                       f32x4 (&acc)[8 / WM][8 / WN], char* smem) {
  constexpr int MI = 8 / WM, NI = 8 / WN;
  const int tid = tidx(), lane = tid & 63, wave = tid >> 6;
  const int wm = wave / WN, wn = wave % WN;
  const int lrow = tid >> 3, lchunk = tid & 7;
  const bf16_t* ga = A + (long)lrow * lda + lchunk * 8;
  const bf16_t* gb = B + (long)lrow * ldb + lchunk * 8;
  uint4 ra[2], rb[2];
  const int KT = K >> 6;
#pragma unroll
  for (int p = 0; p < 2; ++p) {
    ra[p] = *reinterpret_cast<const uint4*>(ga + (long)(p * 64) * lda);
    rb[p] = *reinterpret_cast<const uint4*>(gb + (long)(p * 64) * ldb);
  }
#pragma unroll
  for (int p = 0; p < 2; ++p) {
    int row = p * 64 + lrow;
    int off = row * 128 + ((lchunk ^ (row & 7)) << 4);
    *reinterpret_cast<uint4*>(smem + off) = ra[p];
    *reinterpret_cast<uint4*>(smem + 16384 + off) = rb[p];
  }
  __syncthreads();
  for (int kt = 0; kt < KT; ++kt) {
    const bool more = (kt + 1 < KT);
    if (more) {
      const int k0 = (kt + 1) << 6;
#pragma unroll
      for (int p = 0; p < 2; ++p) {
        ra[p] = *reinterpret_cast<const uint4*>(ga + (long)(p * 64) * lda + k0);
        rb[p] = *reinterpret_cast<const uint4*>(gb + (long)(p * 64) * ldb + k0);
      }
    }
    {
      const char* sa = smem + (kt & 1) * 32768;
      const char* sb = sa + 16384;
#pragma unroll
      for (int ks = 0; ks < 2; ++ks) {
        bf16x8 af[MI], bfr[NI];
        const int ch = ((ks * 4 + (lane >> 4)) ^ (lane & 7)) << 4;
#pragma unroll
        for (int mi = 0; mi < MI; ++mi) {
          int row = wm * (MI * 16) + mi * 16 + (lane & 15);
          af[mi] = *reinterpret_cast<const bf16x8*>(sa + row * 128 + ch);
        }
#pragma unroll
        for (int ni = 0; ni < NI; ++ni) {
          int row = wn * (NI * 16) + ni * 16 + (lane & 15);
          bfr[ni] = *reinterpret_cast<const bf16x8*>(sb + row * 128 + ch);
        }
#pragma unroll
        for (int mi = 0; mi < MI; ++mi)
#pragma unroll
          for (int ni = 0; ni < NI; ++ni)
            acc[mi][ni] = __builtin_amdgcn_mfma_f32_16x16x32_bf16(af[mi], bfr[ni], acc[mi][ni], 0, 0, 0);
      }
    }
    if (more) {
      char* sa = smem + ((kt + 1) & 1) * 32768;
#pragma unroll
      for (int p = 0; p < 2; ++p) {
        int row = p * 64 + lrow;
        int off = row * 128 + ((lchunk ^ (row & 7)) << 4);
        *reinterpret_cast<uint4*>(sa + off) = ra[p];
        *reinterpret_cast<uint4*>(sa + 16384 + off) = rb[p];
      }
    }
    __syncthreads();
  }
}

template <int MI, int NI>
DEV void zero_acc(f32x4 (&acc)[MI][NI]) {
#pragma unroll
  for (int i = 0; i < MI; ++i)
#pragma unroll
    for (int j = 0; j < NI; ++j) acc[i][j] = f32x4{0.f, 0.f, 0.f, 0.f};
}


namespace g8 {
constexpr int BM = 256, BK = 64, HALF = 128, HTB = HALF * BK * 2;
DEV int lds_byte(int r, int c) { const int st = (r >> 4) * 2 + (c >> 5), rr = r & 15, cc = c & 31, ob = rr * 64 + cc * 2; return st * 1024 + (ob ^ (((ob >> 9) & 1) << 5)); }
DEV void stage_rc(int b, int& R, int& C) { const int st = b / 1024, sb = b % 1024, swz = sb ^ (((sb >> 9) & 1) << 5); R = (st >> 1) * 16 + swz / 64; C = (st & 1) * 32 + (swz % 64) / 2; }
DEV int perm32(int rho) { const int n = rho >> 4, i = rho & 15; return 8 * (i >> 2) + 4 * n + (i & 3); }
struct Unit { int pm, pn; };
struct Gemm { const bf16_t* A; const bf16_t* Bt; int lda, ldb, K; };
struct Order {
  int nN, nunits, G, c;
  DEV bool next(int i, Unit& u) const {
    const int L = i * G + c;
    if (c < 0 || L >= nunits) return false;
    u.pm = L / nN; u.pn = L % nN; return true;
  }
};

template <class Epi>
DEV void gemm_phase(LAS unsigned char* lds, const Gemm g, const Order& S, const Epi& E) {
  const int tid = tidx(), wid = __builtin_amdgcn_readfirstlane(tid >> 6), lane = tid & 63, wr = wid >> 2, wc = wid & 3, fr = lane & 15, fq = lane >> 4;
  const int K = g.K, nt = K / BK;
  unsigned voffA[2], voffB[2];
#pragma unroll
  for (int i = 0; i < 2; ++i) { int R, C; stage_rc(tid * 16 + i * 8192, R, C); const int Rb = Epi::PERM ? ((R & ~31) + perm32(R & 31)) : R;
    voffA[i] = (unsigned)(R * g.lda + C) * 2u; voffB[i] = (unsigned)(Rb * g.ldb + C) * 2u; }
  const size_t kstep = (size_t)(BK * 2);
  const size_t hstepA = (size_t)HALF * g.lda * 2, hstepB = (size_t)HALF * g.ldb * 2;
  const size_t tstepA = 2 * hstepA, tstepB = 2 * hstepB;
  const unsigned ldsw = (unsigned)wid * 1024u;
  const int aoff = lds_byte(wr * 64 + fr, fq * 8), boff = lds_byte(wc * 32 + fr, fq * 8);
#define PG8_SA(b, h) (((b) * 2 + (h)) * HTB)
#define PG8_SB(b, h) ((4 + (b) * 2 + (h)) * HTB)
#define PG8_STAGE(bufoff, gbase, voff) do { _Pragma("unroll") for (int _i = 0; _i < 2; ++_i) \
        __builtin_amdgcn_global_load_lds((const unsigned*)((const char*)(gbase) + (voff)[_i]), (LAS unsigned*)(lds + (bufoff) + ldsw + _i * 8192), 16, 0, 0); } while (0)
#define PG8_LDA(dst, b, h) do { _Pragma("unroll") for (int m = 0; m < 4; ++m) _Pragma("unroll") for (int k = 0; k < 2; ++k) dst[m][k] = *(const LAS bf16x8*)(lds + PG8_SA(b, h) + aoff + m * 2048 + k * 1024); } while (0)
#define PG8_LDB(dst, b, h) do { _Pragma("unroll") for (int n = 0; n < 2; ++n) _Pragma("unroll") for (int k = 0; k < 2; ++k) dst[n][k] = *(const LAS bf16x8*)(lds + PG8_SB(b, h) + boff + n * 2048 + k * 1024); } while (0)
#define PG8_MMA(ai, bj, At, Bt) do { __builtin_amdgcn_s_setprio(1); _Pragma("unroll") for (int m = 0; m < 4; ++m) _Pragma("unroll") for (int n = 0; n < 2; ++n) _Pragma("unroll") for (int k = 0; k < 2; ++k) \
        acc[ai][bj][m][n] = __builtin_amdgcn_mfma_f32_16x16x32_bf16(Bt[n][k], At[m][k], acc[ai][bj][m][n], 0, 0, 0); __builtin_amdgcn_s_setprio(0); } while (0)
#define PG8_WAIT_V(n) asm volatile("s_waitcnt vmcnt(" #n ")" ::: "memory")
#define PG8_WAIT_L(n) asm volatile("s_waitcnt lgkmcnt(" #n ")" ::: "memory")
#define PG8_BAR __builtin_amdgcn_s_barrier()
#define PG8_SCHED __builtin_amdgcn_sched_barrier(0)
  Unit cur, nxt; int ui = 0;
  if (!S.next(0, cur)) return;
  f32x4 acc[2][2][4][2];
#pragma unroll
  for (int a = 0; a < 2; ++a)
#pragma unroll
    for (int b = 0; b < 2; ++b)
#pragma unroll
      for (int m = 0; m < 4; ++m)
#pragma unroll
        for (int n = 0; n < 2; ++n) acc[a][b][m][n] = (f32x4){0.f, 0.f, 0.f, 0.f};
  bf16x8 At[4][2], B0[2][2], B1[2][2];
  const char* cA = (const char*)g.A + (size_t)cur.pm * tstepA; const char* cB = (const char*)g.Bt + (size_t)cur.pn * tstepB;
  PG8_STAGE(PG8_SB(0, 0), cB, voffB); PG8_STAGE(PG8_SA(0, 0), cA, voffA); PG8_STAGE(PG8_SB(0, 1), cB + hstepB, voffB); PG8_STAGE(PG8_SA(0, 1), cA + hstepA, voffA);
  if (wr == 1) PG8_BAR;
  PG8_WAIT_V(4); PG8_BAR;
  PG8_STAGE(PG8_SB(1, 0), cB + kstep, voffB); PG8_STAGE(PG8_SA(1, 0), cA + kstep, voffA); PG8_STAGE(PG8_SB(1, 1), cB + hstepB + kstep, voffB);
  PG8_WAIT_V(6); PG8_BAR;
  for (;;) {
    const bool has_next = S.next(ui + 1, nxt);
    const char* nA = has_next ? (const char*)g.A + (size_t)nxt.pm * tstepA : cA; const char* nB = has_next ? (const char*)g.Bt + (size_t)nxt.pn * tstepB : cB;
    for (int t = 0; t < nt; t += 2) {
      const bool last = (t == nt - 2);
      const char* a1 = cA + (size_t)(t + 1) * kstep;
      const char* a2 = last ? nA : cA + (size_t)(t + 2) * kstep; const char* b2 = last ? nB : cB + (size_t)(t + 2) * kstep;
      const char* a3 = a2 + kstep; const char* b3 = b2 + kstep;
      PG8_LDB(B0, 0, 0); PG8_SCHED; PG8_LDA(At, 0, 0); PG8_STAGE(PG8_SA(1, 1), a1 + hstepA, voffA);
      PG8_WAIT_L(8); PG8_BAR; PG8_WAIT_L(0); PG8_MMA(0, 0, At, B0); PG8_BAR; PG8_SCHED;
      PG8_LDB(B1, 0, 1); PG8_STAGE(PG8_SB(0, 0), b2, voffB);
      PG8_BAR; PG8_WAIT_L(0); PG8_MMA(0, 1, At, B1); PG8_BAR;
      PG8_LDA(At, 0, 1); PG8_STAGE(PG8_SA(0, 0), a2, voffA);
      PG8_BAR; PG8_WAIT_L(0); PG8_MMA(1, 0, At, B0); PG8_BAR; PG8_SCHED;
      PG8_STAGE(PG8_SB(0, 1), b2 + hstepB, voffB);
      PG8_WAIT_V(6); PG8_BAR; PG8_MMA(1, 1, At, B1); PG8_BAR;
      PG8_LDB(B0, 1, 0); PG8_SCHED; PG8_LDA(At, 1, 0); PG8_STAGE(PG8_SA(0, 1), a2 + hstepA, voffA);
      PG8_WAIT_L(8); PG8_BAR; PG8_WAIT_L(0); PG8_MMA(0, 0, At, B0); PG8_BAR; PG8_SCHED;
      PG8_LDB(B1, 1, 1); PG8_STAGE(PG8_SB(1, 0), b3, voffB);
      PG8_BAR; PG8_WAIT_L(0); PG8_MMA(0, 1, At, B1); PG8_BAR;
      PG8_LDA(At, 1, 1); PG8_STAGE(PG8_SA(1, 0), a3, voffA);
      PG8_BAR; PG8_WAIT_L(0); PG8_MMA(1, 0, At, B0); PG8_BAR; PG8_SCHED;
      PG8_STAGE(PG8_SB(1, 1), b3 + hstepB, voffB);
      PG8_WAIT_V(6); PG8_BAR; PG8_MMA(1, 1, At, B1); PG8_BAR;
    }
    E(acc, cur, wr, wc, fr, fq);
    if (!has_next) break;
#pragma unroll
    for (int a = 0; a < 2; ++a)
#pragma unroll
      for (int b = 0; b < 2; ++b)
#pragma unroll
        for (int m = 0; m < 4; ++m)
#pragma unroll
          for (int n = 0; n < 2; ++n) acc[a][b][m][n] = (f32x4){0.f, 0.f, 0.f, 0.f};
    cur = nxt; cA = nA; cB = nB; ++ui;
  }
  PG8_WAIT_V(0);
  if (wr == 0) PG8_BAR;
  PG8_BAR;
#undef PG8_SA
#undef PG8_SB
#undef PG8_STAGE
#undef PG8_LDA
#undef PG8_LDB
#undef PG8_MMA
#undef PG8_WAIT_V
#undef PG8_WAIT_L
#undef PG8_BAR
#undef PG8_SCHED
}

struct EpiStoreBf16 {
  static constexpr bool PERM = true;
  bf16_t* O; int ldc;
  DEV void operator()(const f32x4 (&acc)[2][2][4][2], const Unit& u, int wr, int wc, int fr, int fq) const {
    const int row0 = u.pm * BM + wr * 64 + fr, col0 = u.pn * BM + wc * 32 + 8 * fq;
#pragma unroll
    for (int ai = 0; ai < 2; ++ai)
#pragma unroll
      for (int m = 0; m < 4; ++m) {
        bf16_t* rowp = O + (size_t)(row0 + ai * HALF + m * 16) * ldc + col0;
#pragma unroll
        for (int bj = 0; bj < 2; ++bj) {
          const f32x4 v0 = acc[ai][bj][m][0], v1 = acc[ai][bj][m][1];
          *reinterpret_cast<uint4*>(rowp + bj * HALF) = make_uint4(pack2(v0[0], v0[1]), pack2(v0[2], v0[3]), pack2(v1[0], v1[1]), pack2(v1[2], v1[3]));
        }
      }
  }
};
struct EpiFourier {
  static constexpr bool PERM = true;
  bf16_t* YF; int tok0, L; float scale;
  DEV void operator()(const f32x4 (&acc)[2][2][4][2], const Unit& u, int wr, int wc, int fr, int fq) const {
    const int row0 = u.pm * BM + wr * 64 + fr, col0 = wc * 32 + 8 * fq;
#pragma unroll
    for (int ai = 0; ai < 2; ++ai)
#pragma unroll
      for (int m = 0; m < 4; ++m) {
        bf16_t* rowp = YF + (size_t)(tok0 + u.pn * L + row0 + ai * HALF + m * 16) * 256 + col0;
#pragma unroll
        for (int bj = 0; bj < 2; ++bj) {
          const f32x4 v0 = acc[ai][bj][m][0] * scale, v1 = acc[ai][bj][m][1] * scale;
          *reinterpret_cast<uint4*>(rowp + bj * HALF) = make_uint4(pack2(v0[0], v0[1]), pack2(v0[2], v0[3]), pack2(v1[0], v1[1]), pack2(v1[2], v1[3]));
        }
      }
  }
};
struct EpiGate {
  static constexpr bool PERM = true;
  bf16_t* G; const float* bias;
  DEV void operator()(const f32x4 (&acc)[2][2][4][2], const Unit& u, int wr, int wc, int fr, int fq) const {
    const int row0 = u.pm * BM + wr * 64 + fr, col0 = u.pn * BM + wc * 32 + 8 * fq;
#pragma unroll
    for (int bj = 0; bj < 2; ++bj) {
      const float4 b0 = *reinterpret_cast<const float4*>(bias + col0 + bj * HALF);
      const float4 b1 = *reinterpret_cast<const float4*>(bias + col0 + bj * HALF + 4);
#pragma unroll
      for (int ai = 0; ai < 2; ++ai)
#pragma unroll
        for (int m = 0; m < 4; ++m) {
          const f32x4 v0 = acc[ai][bj][m][0], v1 = acc[ai][bj][m][1];
          float g0 = 1.f / (1.f + __expf(-(v0[0] + b0.x))), g1 = 1.f / (1.f + __expf(-(v0[1] + b0.y)));
          float g2 = 1.f / (1.f + __expf(-(v0[2] + b0.z))), g3 = 1.f / (1.f + __expf(-(v0[3] + b0.w)));
          float g4 = 1.f / (1.f + __expf(-(v1[0] + b1.x))), g5 = 1.f / (1.f + __expf(-(v1[1] + b1.y)));
          float g6 = 1.f / (1.f + __expf(-(v1[2] + b1.z))), g7 = 1.f / (1.f + __expf(-(v1[3] + b1.w)));
          *reinterpret_cast<uint4*>(G + (size_t)(row0 + ai * HALF + m * 16) * 1024 + col0 + bj * HALF) =
              make_uint4(pack2(g0, g1), pack2(g2, g3), pack2(g4, g5), pack2(g6, g7));
        }
    }
  }
};
struct EpiMerge {
  static constexpr bool PERM = true;
  const bf16_t* G; bf16_t* MERGED; int first;
  DEV void operator()(const f32x4 (&acc)[2][2][4][2], const Unit& u, int wr, int wc, int fr, int fq) const {
    const int row0 = u.pm * BM + wr * 64 + fr, col0 = u.pn * BM + wc * 32 + 8 * fq;
#pragma unroll
    for (int ai = 0; ai < 2; ++ai) {
      uint4 gv[4][2], pv[4][2];
#pragma unroll
      for (int m = 0; m < 4; ++m)
#pragma unroll
        for (int bj = 0; bj < 2; ++bj) {
          const size_t o = (size_t)(row0 + ai * HALF + m * 16) * 1024 + col0 + bj * HALF;
          gv[m][bj] = *reinterpret_cast<const uint4*>(G + o);
          pv[m][bj] = first ? make_uint4(0u, 0u, 0u, 0u) : *reinterpret_cast<const uint4*>(MERGED + o);
        }
#pragma unroll
      for (int m = 0; m < 4; ++m)
#pragma unroll
        for (int bj = 0; bj < 2; ++bj) {
          const size_t o = (size_t)(row0 + ai * HALF + m * 16) * 1024 + col0 + bj * HALF;
          const uint4 g4 = gv[m][bj], p4 = pv[m][bj];
          const f32x4 v0 = acc[ai][bj][m][0], v1 = acc[ai][bj][m][1];
          float r0 = bflo(g4.x) * v0[0] + bflo(p4.x), r1 = bfhi(g4.x) * v0[1] + bfhi(p4.x);
          float r2 = bflo(g4.y) * v0[2] + bflo(p4.y), r3 = bfhi(g4.y) * v0[3] + bfhi(p4.y);
          float r4 = bflo(g4.z) * v1[0] + bflo(p4.z), r5 = bfhi(g4.z) * v1[1] + bfhi(p4.z);
          float r6 = bflo(g4.w) * v1[2] + bflo(p4.w), r7 = bfhi(g4.w) * v1[3] + bfhi(p4.w);
          *reinterpret_cast<uint4*>(MERGED + o) = make_uint4(pack2(r0, r1), pack2(r2, r3), pack2(r4, r5), pack2(r6, r7));
        }
    }
  }
};
struct EpiResid {
  static constexpr bool PERM = true;
  float* out; float* Xc; const float* mod;
  const float* sx; const float* sc;
  DEV void operator()(const f32x4 (&acc)[2][2][4][2], const Unit& u, int wr, int wc, int fr, int fq) const {
    const int t0 = u.pm * BM;
    const int mr = t0 < NXTOK ? (t0 >> 12) : 8;
    float* xb = t0 < NXTOK ? out + (size_t)t0 * 1024 : Xc + (size_t)(t0 - NXTOK) * 1024;
    const float* xs = t0 < NXTOK ? sx + (size_t)t0 * 1024 : sc + (size_t)(t0 - NXTOK) * 1024;
    const float* gp = mod + (size_t)mr * 6144;
    const int rl0 = wr * 64 + fr, col0 = u.pn * BM + wc * 32 + 8 * fq;
#pragma unroll
    for (int bj = 0; bj < 2; ++bj)
#pragma unroll
      for (int n = 0; n < 2; ++n) {
        const int col = col0 + bj * HALF + n * 4;
        const float4 g = *reinterpret_cast<const float4*>(gp + col);
        float4 xin[2][4];
#pragma unroll
        for (int ai = 0; ai < 2; ++ai)
#pragma unroll
          for (int m = 0; m < 4; ++m)
            xin[ai][m] = *reinterpret_cast<const float4*>(xs + (size_t)(rl0 + ai * HALF + m * 16) * 1024 + col);
#pragma unroll
        for (int ai = 0; ai < 2; ++ai)
#pragma unroll
          for (int m = 0; m < 4; ++m) {
            const size_t xo = (size_t)(rl0 + ai * HALF + m * 16) * 1024 + col;
            float4 xv = xin[ai][m];
            const f32x4 a = acc[ai][bj][m][n];
            xv.x += g.x * a[0]; xv.y += g.y * a[1]; xv.z += g.z * a[2]; xv.w += g.w * a[3];
            *reinterpret_cast<float4*>(xb + xo) = xv;
          }
      }
  }
};
struct EpiAny {
  static constexpr bool PERM = true;
  int kind;
  const void *p0, *p1, *p2, *p3, *p4;
  int i0, i1; float f0;
  DEV void operator()(const f32x4 (&acc)[2][2][4][2], const Unit& u, int wr, int wc, int fr, int fq) const {
    asm volatile("" : "+v"(fr), "+v"(fq));
    switch (kind) {
      case 0: EpiStoreBf16{(bf16_t*)p0, i0}(acc, u, wr, wc, fr, fq); break;
      case 1: EpiFourier{(bf16_t*)p0, i0, i1, f0}(acc, u, wr, wc, fr, fq); break;
      case 2: EpiGate{(bf16_t*)p0, (const float*)p1}(acc, u, wr, wc, fr, fq); break;
      case 3: EpiMerge{(const bf16_t*)p0, (bf16_t*)p1, i0}(acc, u, wr, wc, fr, fq); break;
      default: EpiResid{(float*)p0, (float*)p1, (const float*)p2, (const float*)p3, (const float*)p4}(acc, u, wr, wc, fr, fq); break;
    }
  }
};
}

DEV void transpose_cvt(const float* __restrict__ src, int ldsrc, int K, int N, bf16_t* __restrict__ dst, int lddst,
                       int& base, char* smem) {
  float(*tile)[65] = reinterpret_cast<float(*)[65]>(smem);
  const int G = gdim();
  const int nkt = K >> 6, nnt = (N + 63) >> 6;
  const int ntile = nkt * nnt;
  int start = (bidx() - base) % G;
  if (start < 0) start += G;
  const int tid = tidx();
  for (int t = start; t < ntile; t += G) {
    const int kt = t % nkt, nt = t / nkt;
    const int k0 = kt << 6, n0 = nt << 6;
    {
      const int n = tid & 63;
      const bool okn = (n0 + n) < N;
#pragma unroll
      for (int p = 0; p < 8; ++p) {
        const int kk = (tid >> 6) + p * 8;
        tile[kk][n] = okn ? src[(size_t)(k0 + kk) * ldsrc + n0 + n] : 0.f;
      }
    }
    __syncthreads();
    {
      const int n = tid >> 3, kc = tid & 7;
      if (n0 + n < N) {
        unsigned w[4];
#pragma unroll
        for (int i = 0; i < 4; ++i) w[i] = pack2(tile[kc * 8 + 2 * i][n], tile[kc * 8 + 2 * i + 1][n]);
        *reinterpret_cast<uint4*>(dst + (size_t)(n0 + n) * lddst + k0 + kc * 8) = make_uint4(w[0], w[1], w[2], w[3]);
      }
    }
    __syncthreads();
  }
  base = (base + ntile) % G;
}

DEV void cvt_bf16(const float* __restrict__ src, bf16_t* __restrict__ dst, size_t n8) {
  const size_t gsz = (size_t)gdim() * NTHR;
  for (size_t i = (size_t)bidx() * NTHR + tidx(); i < n8; i += gsz) {
    float4 a = reinterpret_cast<const float4*>(src)[2 * i];
    float4 b = reinterpret_cast<const float4*>(src)[2 * i + 1];
    reinterpret_cast<uint4*>(dst)[i] = make_uint4(pack2(a.x, a.y), pack2(a.z, a.w), pack2(b.x, b.y), pack2(b.z, b.w));
  }
}

DEV void phase_prep(const Params& p, char* smem) {
  const int tid = tidx();
  const size_t gtid = (size_t)bidx() * NTHR + tid, gsz = (size_t)gdim() * NTHR;
  {
    const int lane = tid & 63;
    const int gw = bidx() * NWAVE + (tid >> 6), nw = gdim() * NWAVE;
    for (int r0 = gw * 4; r0 < 4 * 16384; r0 += nw * 4) {
      float4 v[4][4];
#pragma unroll
      for (int u = 0; u < 4; ++u) {
        const int r = r0 + u;
        const int tab = r >> 15, row = r & 32767;
        const float* src = (tab ? p.peer_up : p.peer_down) + (size_t)row * 1024 + lane * 16;
#pragma unroll
        for (int i = 0; i < 4; ++i) v[u][i] = reinterpret_cast<const float4*>(src)[i];
      }
#pragma unroll
      for (int u = 0; u < 4; ++u) {
        const int r = r0 + u;
        const int tab = r >> 15, row = r & 32767;
        float am = 0.f;
#pragma unroll
        for (int i = 0; i < 4; ++i)
          am = fmaxf(am, fmaxf(fmaxf(fabsf(v[u][i].x), fabsf(v[u][i].y)), fmaxf(fabsf(v[u][i].z), fabsf(v[u][i].w))));
        am = wave_max_f(am);
        const float inv = am > 0.f ? 5.9f / am : 0.f;
        const float scl = am > 0.f ? am / 5.9f : 0.f;
        unsigned w0 = 0u, w1 = 0u;
        w0 = __builtin_amdgcn_cvt_scalef32_pk_fp4_f32(w0, v[u][0].x * inv, v[u][0].y * inv, 1.0f, 0);
        w0 = __builtin_amdgcn_cvt_scalef32_pk_fp4_f32(w0, v[u][0].z * inv, v[u][0].w * inv, 1.0f, 1);
        w0 = __builtin_amdgcn_cvt_scalef32_pk_fp4_f32(w0, v[u][1].x * inv, v[u][1].y * inv, 1.0f, 2);
        w0 = __builtin_amdgcn_cvt_scalef32_pk_fp4_f32(w0, v[u][1].z * inv, v[u][1].w * inv, 1.0f, 3);
        w1 = __builtin_amdgcn_cvt_scalef32_pk_fp4_f32(w1, v[u][2].x * inv, v[u][2].y * inv, 1.0f, 0);
        w1 = __builtin_amdgcn_cvt_scalef32_pk_fp4_f32(w1, v[u][2].z * inv, v[u][2].w * inv, 1.0f, 1);
        w1 = __builtin_amdgcn_cvt_scalef32_pk_fp4_f32(w1, v[u][3].x * inv, v[u][3].y * inv, 1.0f, 2);
        w1 = __builtin_amdgcn_cvt_scalef32_pk_fp4_f32(w1, v[u][3].z * inv, v[u][3].w * inv, 1.0f, 3);
        unsigned char* dst = (tab ? p.PU8 : p.PD8) + (size_t)row * 512 + lane * 8;
        *reinterpret_cast<uint2*>(dst) = make_uint2(w0, w1);
        if (lane == 0) (tab ? p.SU : p.SD)[row] = scl;
      }
    }
  }
  cvt_bf16(p.peer_keys, p.KEYS, (size_t)2 * 16 * 128 * 16);
  for (size_t i = gtid; i < (size_t)4096 * 1024; i += gsz) {
    int k = (int)(i >> 10), j0 = (int)(i & 1023) * 8;
    int part = j0 >= 4096;
    int jj = j0 - (part ? 4096 : 0);
    float v[8];
#pragma unroll
    for (int e = 0; e < 8; ++e) {
      int ph = (k * (jj + e)) & 4095;
      v[e] = __builtin_amdgcn_cosf((float)ph * (1.0f / 4096.0f) - (part ? 0.25f : 0.f));
    }
    reinterpret_cast<uint4*>(p.A2)[i] = make_uint4(pack2(v[0], v[1]), pack2(v[2], v[3]), pack2(v[4], v[5]), pack2(v[6], v[7]));
  }
  for (size_t i = gtid; i < (size_t)256 * 64; i += gsz) {
    int k = (int)(i >> 6), j0 = (int)(i & 63) * 8;
    int part = j0 >= 256;
    int jj = j0 - (part ? 256 : 0);
    float v[8];
#pragma unroll
    for (int e = 0; e < 8; ++e) {
      int ph = (k * (jj + e)) & 255;
      float a = (float)ph * (1.0f / 128.0f);
      v[e] = part ? sinpif(a) : cospif(a);
    }
    reinterpret_cast<uint4*>(p.A2c)[i] = make_uint4(pack2(v[0], v[1]), pack2(v[2], v[3]), pack2(v[4], v[5]), pack2(v[6], v[7]));
  }
  for (size_t i = gtid; i < (size_t)512 * 32; i += gsz) {
    int r = (int)(i >> 5), c0 = (int)(i & 31) * 8;
    int m = r & 255, part = r >> 8;
    float v[8];
#pragma unroll
    for (int e = 0; e < 8; ++e) {
      int ph = (m * (c0 + e)) & 255;
      float a = (float)ph * (1.0f / 128.0f);
      v[e] = part ? -sinpif(a) : cospif(a);
    }
    reinterpret_cast<uint4*>(p.CS)[i] = make_uint4(pack2(v[0], v[1]), pack2(v[2], v[3]), pack2(v[4], v[5]), pack2(v[6], v[7]));
  }
  for (size_t i = gtid; i < 512; i += gsz) {
    const int pos = (int)(i >> 3), fi = (int)(i & 7);
    float ang = (float)pos * __expf(-(float)fi * 1.1512925465f);
    float sn, cs;
    sincosf(ang, &sn, &cs);
    p.ROPE[2 * i] = cs; p.ROPE[2 * i + 1] = sn;
  }
  for (size_t i = gtid; i < (size_t)2 * 256 * 1024; i += gsz) {
    int l = (int)(i >> 18), gc = (int)((i >> 10) & 255), d = (int)(i & 1023);
    int g = gc >> 6;
    const float* wg = p.w_grp + ((size_t)l * 256 + gc) * 64;
    const float* ps = p.pool_scale + l * 256 + g * 64;
    const float* wo = p.w_oc + ((size_t)l * 256 + g * 64) * 1024 + d;
    float s = 0.f;
    for (int j = 0; j < 64; ++j) s += wg[j] * ps[j] * wo[(size_t)j * 1024];
    p.WpcT[((size_t)l * 1024 + d) * 256 + gc] = f2bf(s);
  }
  for (size_t i = gtid; i < (size_t)2 * 96 * 128; i += gsz) {
    int l = (int)(i / (96 * 128));
    size_t r = i % (96 * 128);
    reinterpret_cast<uint4*>(p.WinT + ((size_t)l * 4096 + 928) * 1024)[r] = make_uint4(0, 0, 0, 0);
  }
  {
    float* sc = reinterpret_cast<float*>(smem);
    float* red = sc + 9 * 1024;
    bool loaded = false;
    for (int job = bidx(); job < 192; job += gdim()) {
      if (!loaded) {
        for (int i = tid; i < 9 * 1024; i += NTHR) {
          float v = (i < 8192) ? p.c[i] : p.c_ctx[i - 8192];
          sc[i] = v / (1.f + __expf(-v));
        }
        loaded = true;
      }
      __syncthreads();
      const int l = job / 96, c0 = (job % 96) * 64;
      {
        const int ks = tid >> 6, cl = tid & 63;
        const float* wp = p.w_mod + ((size_t)l * 1024 + ks * 128) * 6144 + c0 + cl;
        float a[9];
#pragma unroll
        for (int r = 0; r < 9; ++r) a[r] = 0.f;
#pragma unroll 2
        for (int k = 0; k < 128; k += 8) {
          float w[8];
#pragma unroll
          for (int e = 0; e < 8; ++e) w[e] = wp[(size_t)(k + e) * 6144];
#pragma unroll
          for (int r = 0; r < 9; ++r) {
            const float* sv = sc + r * 1024 + ks * 128 + k;
#pragma unroll
            for (int e = 0; e < 8; ++e) a[r] += sv[e] * w[e];
          }
        }
#pragma unroll
        for (int r = 0; r < 9; ++r) red[(ks * 9 + r) * 64 + cl] = a[r];
      }
      __syncthreads();
      for (int i = tid; i < 9 * 64; i += NTHR) {
        int r = i >> 6, cc = i & 63;
        float s = 0.f;
#pragma unroll
        for (int q = 0; q < 8; ++q) s += red[(q * 9 + r) * 64 + cc];
        p.MOD[((size_t)l * 9 + r) * 6144 + c0 + cc] = s + p.b_mod[l * 6144 + c0 + cc];
      }
      __syncthreads();
    }
    __syncthreads();
  }
  int base = 0;
  for (int l = 0; l < 2; ++l) {
    transpose_cvt(p.w_in + (size_t)l * 1024 * 4000, 4000, 1024, 928, p.WinT + (size_t)l * 4096 * 1024, 1024, base, smem);
    transpose_cvt(p.w_in + (size_t)l * 1024 * 4000 + 928, 4000, 1024, 3072, p.WinT + ((size_t)l * 4096 + 1024) * 1024,
                  1024, base, smem);
    transpose_cvt(p.w_uq + (size_t)l * 256 * 768, 768, 256, 768, p.WuqT + (size_t)l * 768 * 256, 256, base, smem);
    transpose_cvt(p.w_ukv + (size_t)l * 128 * 1024, 1024, 128, 1024, p.WukvT + (size_t)l * 1024 * 128, 128, base, smem);
    transpose_cvt(p.w_oa + (size_t)l * 512 * 1024, 1024, 512, 1024, p.WoaT + (size_t)l * 1024 * 512, 512, base, smem);
    transpose_cvt(p.w_ob + (size_t)l * 256 * 1024, 1024, 256, 1024, p.WobT + (size_t)l * 1024 * 256, 256, base, smem);
    transpose_cvt(p.w_out + (size_t)l * 1024 * 1024, 1024, 1024, 1024, p.WoutT + (size_t)l * 1024 * 1024, 1024, base, smem);
    transpose_cvt(p.w_pq + (size_t)l * 1024 * 2048, 2048, 1024, 2048, p.WpqT + (size_t)l * 2048 * 1024, 1024, base, smem);
  }
}

DEV void phase_ln(const Params& p, int l, const float* __restrict__ g, int shift_chunk, int ntok, bool from_input) {
  const int lane = tidx() & 63;
  const int gw = bidx() * NWAVE + (tidx() >> 6), nw = gdim() * NWAVE;
  for (int t = gw; t < ntok; t += nw) {
    const float* xr = from_input ? (t < NXTOK ? p.x + (size_t)t * 1024 : p.ctx + (size_t)(t - NXTOK) * 1024) : xrow(p, t);
    const int mr = t < NXTOK ? (t >> 12) : 8;
    const float* mod = p.MOD + ((size_t)l * 9 + mr) * 6144 + shift_chunk * 1024;
    float4 v[4];
    float ss = 0.f;
#pragma unroll
    for (int i = 0; i < 4; ++i) {
      v[i] = *reinterpret_cast<const float4*>(xr + i * 256 + lane * 4);
      ss += v[i].x * v[i].x + v[i].y * v[i].y + v[i].z * v[i].z + v[i].w * v[i].w;
    }
    ss = wave_sum(ss);
    const float rs = rsqrtf(ss * (1.f / 1024.f) + 1e-6f);
#pragma unroll
    for (int i = 0; i < 4; ++i) {
      const int cidx = i * 256 + lane * 4;
      float4 g4 = *reinterpret_cast<const float4*>(g + cidx);
      float4 sh = *reinterpret_cast<const float4*>(mod + cidx);
      float4 sc = *reinterpret_cast<const float4*>(mod + 1024 + cidx);
      float h0 = v[i].x * rs * g4.x * (1.f + sc.x) + sh.x;
      float h1 = v[i].y * rs * g4.y * (1.f + sc.y) + sh.y;
      float h2 = v[i].z * rs * g4.z * (1.f + sc.z) + sh.z;
      float h3 = v[i].w * rs * g4.w * (1.f + sc.w) + sh.w;
      *reinterpret_cast<uint2*>(p.H + (size_t)t * 1024 + cidx) = make_uint2(pack2(h0, h1), pack2(h2, h3));
    }
  }
}

DEV void phase_c1(const Params& p, int l) {
  const int lane = tidx() & 63;
  const int gw = bidx() * NWAVE + (tidx() >> 6), nw = gdim() * NWAVE;
  bf16_t* ZF = p.S1;
  bf16_t* Kb = p.R2 + (size_t)NTOK * 768;
  const int chunk = (NTOK + nw - 1) / nw;
  for (int ti = 0; ti < chunk; ++ti) {
    const int t = gw * chunk + ti;
    if (t >= NTOK) break;
    bf16_t* zr = ZF + (size_t)t * 1024;
    int b, lpos, L, tb, key;
    if (t < NXTOK) { b = t >> 12; lpos = t & 4095; L = 4096; tb = b * 4096; key = 256 + lpos; }
    else { int cidx = t - NXTOK; b = cidx >> 8; lpos = cidx & 255; L = 256; tb = NXTOK + b * 256; key = lpos; }
    const uint2 ucq = *reinterpret_cast<const uint2*>(zr + lane * 4);
    const unsigned uckv = *reinterpret_cast<const unsigned*>(zr + 256 + lane * 2);
    const int d = lane & 31;
    const bf16_t ukr = zr[384 + d];
    bf16_t pv[4][16], pself[4];
#pragma unroll
    for (int gi = 0; gi < 4; ++gi) {
      const int w = 2 << gi;
      const bf16_t* src = ZF + (size_t)tb * 1024 + 672 + gi * 64 + lane;
#pragma unroll
      for (int jj = 0; jj < w; ++jj) {
        int j = lpos - w / 2 + jj;
        int jc = j < 0 ? 0 : (j >= L ? L - 1 : j);
        pv[gi][jj] = src[(size_t)jc * 1024];
      }
      pself[gi] = src[(size_t)lpos * 1024];
    }
    const float4 gq = *reinterpret_cast<const float4*>(p.q_norm_g + l * 256 + lane * 4);
    const float2 gkv = *reinterpret_cast<const float2*>(p.kv_norm_g + l * 128 + lane * 2);
    {
      float a0 = bflo(ucq.x), a1 = bfhi(ucq.x), a2 = bflo(ucq.y), a3 = bfhi(ucq.y);
      float ss = wave_sum(a0 * a0 + a1 * a1 + a2 * a2 + a3 * a3);
      float rs = rsqrtf(ss * (1.f / 256.f) + 1e-6f);
      *reinterpret_cast<uint2*>(zr + lane * 4) = make_uint2(pack2(a0 * rs * gq.x, a1 * rs * gq.y), pack2(a2 * rs * gq.z, a3 * rs * gq.w));
    }
    {
      float a0 = bflo(uckv), a1 = bfhi(uckv);
      float ss = wave_sum(a0 * a0 + a1 * a1);
      float rs = rsqrtf(ss * (1.f / 128.f) + 1e-6f);
      *reinterpret_cast<unsigned*>(zr + 256 + lane * 2) = pack2(a0 * rs * gkv.x, a1 * rs * gkv.y);
    }
    {
      float val = bf2f(ukr);
      float partner = __shfl_xor(val, 8);
      float outv = val;
      if (t < NXTOK) {
        int i = d & 7;
        float pos = (float)((d < 16) ? (lpos >> 6) : (lpos & 63));
        const float2 csn = *reinterpret_cast<const float2*>(p.ROPE + ((int)pos * 8 + i) * 2);
        const float cs = csn.x, sn = csn.y;
        outv = (d & 8) ? (partner * sn + val * cs) : (val * cs - partner * sn);
      }
      if (lane < 32) {
        bf16_t ob = f2bf(outv);
#pragma unroll
        for (int h = 0; h < 8; ++h) Kb[((size_t)(b * 8 + h) * NKEY + key) * 96 + 64 + d] = ob;
      }
    }
#pragma unroll
    for (int gi = 0; gi < 4; ++gi) {
      const int w = 2 << gi;
      int lo = lpos - w / 2; if (lo < 0) lo = 0;
      int hi = lpos - w / 2 + w; if (hi > L) hi = L;
      float s2 = 0.f;
#pragma unroll
      for (int jj = 0; jj < w; ++jj) {
        int j = lpos - w / 2 + jj;
        s2 += (j >= 0 && j < L) ? bf2f(pv[gi][jj]) : 0.f;
      }
      p.POOLED[(size_t)t * 256 + gi * 64 + lane] = f2bf(s2 / (float)(hi - lo) - bf2f(pself[gi]));
    }
  }
}

DEV void phase_c2(const Params& p, int l, int ntt, char* smem) {
  const int lane = tidx() & 63, wave = tidx() >> 6;
  const int wm = wave >> 2, wn = wave & 3;
  const int quad = lane >> 4, l15 = lane & 15;
  const bf16_t* ZF = p.S1;
  bf16_t* Q = p.R2;
  bf16_t* Kb = p.R2 + (size_t)NTOK * 768;
  bf16_t* Vt = Kb + (size_t)64 * NKEY * 96;
  const int nq = ntt * 6, nkv = (NTOK / 128) * 8, nf = ntt * 4;
  const int total = nq + nkv + nf;
  for (int tile = xcd_remap(bidx(), gdim()); tile < total; tile += gdim()) {
    f32x4 acc[4][2];
    zero_acc(acc);
    if (tile < nq) {
      const int tt = tile / 6, tn = tile % 6;
      const int t0 = tt * 128, m0 = tn * 128;
      gemm_mainloop<2, 4>(p.WuqT + ((size_t)l * 768 + m0) * 256, 256, ZF + (size_t)t0 * 1024, 1024, 256, acc, smem);
      const float qs = 0.10206207261596577f * 1.4426950408889634f;
#pragma unroll
      for (int mi = 0; mi < 4; ++mi) {
        const int cb = m0 + wm * 64 + mi * 16;
        const int hc = cb % 96;
        const int ropek = hc < 64 ? 0 : (hc == 64 ? 1 : 2);
#pragma unroll
        for (int ni = 0; ni < 2; ++ni) {
          const int t = t0 + wn * 32 + ni * 16 + l15;
          float o[4];
#pragma unroll
          for (int j = 0; j < 4; ++j) {
            float v = acc[mi][ni][j];
            float partner = __shfl_xor(v, 32);
            float r = v;
            if (ropek != 0 && t < NXTOK) {
              int lpos = t & 4095;
              int i = (quad & 1) * 4 + j;
              float pos = (float)(ropek == 1 ? (lpos >> 6) : (lpos & 63));
              const float2 csn = *reinterpret_cast<const float2*>(p.ROPE + ((int)pos * 8 + i) * 2);
              const float cs = csn.x, sn = csn.y;
              r = (quad & 2) ? (partner * sn + v * cs) : (v * cs - partner * sn);
            }
            o[j] = r * qs;
          }
          *reinterpret_cast<uint2*>(Q + (size_t)t * 768 + cb + quad * 4) = make_uint2(pack2(o[0], o[1]), pack2(o[2], o[3]));
        }
      }
    } else if (tile < nq + nkv) {
      const int tl = tile - nq;
      const int tt = tl >> 3, h = tl & 7;
      const int t0 = tt * 128;
      gemm_mainloop<2, 4>(p.WukvT + ((size_t)l * 1024 + h * 128) * 128, 128, ZF + (size_t)t0 * 1024 + 256, 1024, 128, acc, smem);
#pragma unroll
      for (int mi = 0; mi < 4; ++mi)
#pragma unroll
        for (int ni = 0; ni < 2; ++ni) {
          const int t = t0 + wn * 32 + ni * 16 + l15;
          int b, key;
          if (t < NXTOK) { b = t >> 12; key = 256 + (t & 4095); }
          else { int ci = t - NXTOK; b = ci >> 8; key = ci & 255; }
          const int cc = mi * 16 + quad * 4;
          if (wm == 0) {
            *reinterpret_cast<uint2*>(Kb + ((size_t)(b * 8 + h) * NKEY + key) * 96 + cc) =
                make_uint2(pack2(acc[mi][ni][0], acc[mi][ni][1]), pack2(acc[mi][ni][2], acc[mi][ni][3]));
          } else {
            bf16_t* vt_s = reinterpret_cast<bf16_t*>(smem);
#pragma unroll
            for (int j = 0; j < 4; ++j) vt_s[(cc + j) * 136 + (wn * 32 + ni * 16 + l15)] = f2bf(acc[mi][ni][j]);
          }
        }
      __syncthreads();
      {
        int b, key0;
        if (t0 < NXTOK) { b = t0 >> 12; key0 = 256 + (t0 & 4095); }
        else { int ci = t0 - NXTOK; b = ci >> 8; key0 = ci & 255; }
        const bf16_t* vt_s = reinterpret_cast<const bf16_t*>(smem);
#pragma unroll
        for (int q = 0; q < 2; ++q) {
          const int id = tidx() + q * 512;
          const int d = id >> 4, c8 = id & 15;
          const uint4 v8 = *reinterpret_cast<const uint4*>(vt_s + d * 136 + c8 * 8);
          *reinterpret_cast<uint4*>(Vt + ((size_t)(b * 8 + h) * 64 + d) * NKEY + key0 + c8 * 8) = v8;
        }
      }
      __syncthreads();
    } else {
      const int tl = tile - nq - nkv;
      const int tt = tl >> 2, tn = tl & 3;
      const int t0 = tt * 128, n0 = tn * 128;
      gemm_mainloop<2, 4>(ZF + (size_t)t0 * 1024 + 416, 1024, p.CS + (size_t)n0 * 256, 256, 256, acc, smem);
#pragma unroll
      for (int mi = 0; mi < 4; ++mi)
#pragma unroll
        for (int ni = 0; ni < 2; ++ni) {
          const int t = t0 + wm * 64 + mi * 16 + quad * 4;
          const int r = n0 + wn * 32 + ni * 16 + l15;
          const int m = r & 255, part = r >> 8;
          uint2 val = make_uint2(pack2(acc[mi][ni][0], acc[mi][ni][1]), pack2(acc[mi][ni][2], acc[mi][ni][3]));
          if (t < NXTOK) {
            int b = t >> 12, lp = t & 4095;
            *reinterpret_cast<uint2*>(p.UTx + ((size_t)(b * 256 + m)) * 8192 + part * 4096 + lp) = val;
          } else {
            int ci = t - NXTOK;
            int b = ci >> 8, lp = ci & 255;
            *reinterpret_cast<uint2*>(p.UTc + ((size_t)(b * 256 + m)) * 512 + part * 256 + lp) = val;
          }
        }
    }
  }
}

constexpr int ATT_BUF = 16384 + 64 * 136;

constexpr int ATT_KB = 16384, ATT_VB = 64 * 136, ATT_VOFF = 2 * ATT_KB;
DEV void attn_item(const Params& p, int b, int h, int q_t0, int nkt, char* smem) {
  const int tid = tidx(), lane = tid & 63, wave = tid >> 6;
  const int quad = lane >> 4, l15 = lane & 15;
  const bf16_t* Q = p.R2;
  const bf16_t* Kb = p.R2 + (size_t)NTOK * 768;
  const bf16_t* Vt = Kb + (size_t)64 * NKEY * 96;
  bf16_t* ATT = p.S1;
  bf16x8 qf[2][3];
#pragma unroll
  for (int qb = 0; qb < 2; ++qb) {
    const int t = q_t0 + wave * 32 + qb * 16 + l15;
#pragma unroll
    for (int s = 0; s < 3; ++s)
      qf[qb][s] = *reinterpret_cast<const bf16x8*>(Q + (size_t)t * 768 + h * 96 + s * 32 + quad * 8);
  }
  const bf16_t* kbase = Kb + (size_t)(b * 8 + h) * NKEY * 96;
  const bf16_t* vbase = Vt + (size_t)(b * 8 + h) * 64 * NKEY;
  f32x4 oacc[2][4];
  zero_acc(oacc);
  float m_run[2] = {-1e30f, -1e30f}, l_run[2] = {0.f, 0.f};
  const int kr0 = tid / 12, kc0 = tid % 12;
  const int kr1 = (tid + 512) / 12, kc1 = (tid + 512) % 12;
  const bool k2 = tid < 256;
  const int vd0 = tid >> 3, vkc = tid & 7;
  const bf16_t* gk0 = kbase + (size_t)kr0 * 96 + kc0 * 8;
  const bf16_t* gk1 = kbase + (size_t)kr1 * 96 + kc1 * 8;
  const bf16_t* gv = vbase + (size_t)vd0 * NKEY + vkc * 8;
  const int sk0 = kr0 * 256 + ((kc0 ^ (kr0 & 15)) << 4);
  const int sk1 = kr1 * 256 + ((kc1 ^ (kr1 & 15)) << 4);
  const int sv0 = ATT_VOFF + vd0 * 136 + vkc * 16;
  uint4 rk0, rk1 = make_uint4(0u, 0u, 0u, 0u), rv;
#define ATT_LDK(KT) { const size_t ko = (size_t)(KT) * 64 * 96; rk0 = *reinterpret_cast<const uint4*>(gk0 + ko); if (k2) rk1 = *reinterpret_cast<const uint4*>(gk1 + ko); }
#define ATT_LDV(KT) { rv = *reinterpret_cast<const uint4*>(gv + (size_t)(KT) * 64); }
#define ATT_STK(BUF) { char* sb_ = smem + (BUF) * ATT_KB; *reinterpret_cast<uint4*>(sb_ + sk0) = rk0; if (k2) *reinterpret_cast<uint4*>(sb_ + sk1) = rk1; }
#define ATT_STV(BUF) { char* sb_ = smem + (BUF) * ATT_VB; *reinterpret_cast<uint2*>(sb_ + sv0) = make_uint2(rv.x, rv.y); *reinterpret_cast<uint2*>(sb_ + sv0 + 8) = make_uint2(rv.z, rv.w); }
  auto qk = [&](int kbuf, f32x4 (&s)[2][4]) {
    const char* sk = smem + kbuf * ATT_KB;
    zero_acc(s);
    bf16x8 kf[4][3];
#pragma unroll
    for (int kb = 0; kb < 4; ++kb)
#pragma unroll
      for (int st = 0; st < 3; ++st) {
        const int row = kb * 16 + l15;
        const int chunk = st * 4 + quad;
        kf[kb][st] = *reinterpret_cast<const bf16x8*>(sk + row * 256 + ((chunk ^ l15) << 4));
      }
    __builtin_amdgcn_sched_barrier(0);
#pragma unroll
    for (int kb = 0; kb < 4; ++kb)
#pragma unroll
      for (int st = 0; st < 3; ++st)
#pragma unroll
        for (int qb = 0; qb < 2; ++qb) s[qb][kb] = __builtin_amdgcn_mfma_f32_16x16x32_bf16(kf[kb][st], qf[qb][st], s[qb][kb], 0, 0, 0);
  };
  auto softmax_pv = [&](int vbuf, f32x4 (&s)[2][4]) {
    const char* sv = smem + ATT_VOFF + vbuf * ATT_VB;
#pragma unroll
    for (int qb = 0; qb < 2; ++qb) {
      float mx = fmaxf(fmaxf(s[qb][0][0], s[qb][0][1]), fmaxf(s[qb][0][2], s[qb][0][3]));
#pragma unroll
      for (int kb = 1; kb < 4; ++kb)
        mx = fmaxf(mx, fmaxf(fmaxf(s[qb][kb][0], s[qb][kb][1]), fmaxf(s[qb][kb][2], s[qb][kb][3])));
      mx = xmax16(mx);
      mx = xmax32(mx);
      if (__builtin_amdgcn_ballot_w64(mx > m_run[qb] + 6.f) != 0ull) {
        const float mn = fmaxf(m_run[qb], mx);
        const float alpha = __builtin_amdgcn_exp2f(m_run[qb] - mn);
        m_run[qb] = mn;
        l_run[qb] *= alpha;
#pragma unroll
        for (int db = 0; db < 4; ++db) {
          oacc[qb][db][0] *= alpha; oacc[qb][db][1] *= alpha; oacc[qb][db][2] *= alpha; oacc[qb][db][3] *= alpha;
        }
      }
      const f32x2 mref2 = f32x2{m_run[qb], m_run[qb]};
      f32x2 ps2 = f32x2{0.f, 0.f};
#pragma unroll
      for (int kb = 0; kb < 4; ++kb)
#pragma unroll
        for (int jp = 0; jp < 2; ++jp) {
          f32x2 x = f32x2{s[qb][kb][2 * jp], s[qb][kb][2 * jp + 1]} - mref2;
          f32x2 e = f32x2{__builtin_amdgcn_exp2f(x[0]), __builtin_amdgcn_exp2f(x[1])};
          s[qb][kb][2 * jp] = e[0];
          s[qb][kb][2 * jp + 1] = e[1];
          ps2 += e;
        }
      l_run[qb] += ps2[0] + ps2[1];
    }
    bf16x8 vf[2][4];
#pragma unroll
    for (int ks = 0; ks < 2; ++ks)
#pragma unroll
      for (int db = 0; db < 4; ++db) {
        const int d = db * 16 + l15;
        uint2 lo = *reinterpret_cast<const uint2*>(sv + d * 136 + (ks * 32 + quad * 4) * 2);
        uint2 hi = *reinterpret_cast<const uint2*>(sv + d * 136 + (ks * 32 + 16 + quad * 4) * 2);
        vf[ks][db] = mk8(lo, hi);
      }
    __builtin_amdgcn_sched_barrier(0);
#pragma unroll
    for (int ks = 0; ks < 2; ++ks) {
      bf16x8 pf[2];
#pragma unroll
      for (int qb = 0; qb < 2; ++qb) pf[qb] = pack8(s[qb][2 * ks], s[qb][2 * ks + 1]);
#pragma unroll
      for (int db = 0; db < 4; ++db)
#pragma unroll
        for (int qb = 0; qb < 2; ++qb) oacc[qb][db] = __builtin_amdgcn_mfma_f32_16x16x32_bf16(vf[ks][db], pf[qb], oacc[qb][db], 0, 0, 0);
    }
  };
  f32x4 sA[2][4], sB[2][4];
  ATT_LDK(0) ATT_LDV(0)
  ATT_STK(0) ATT_STV(0)
  if (nkt > 1) { ATT_LDK(1) ATT_STK(1) }
  __syncthreads();
  qk(0, sA);
  if (nkt > 2) ATT_LDK(2)
  if (nkt > 1) ATT_LDV(1)
  __syncthreads();
  for (int t = 0; t < nkt; t += 2) {
    if (t + 1 < nkt) qk(1, sB);
    softmax_pv(0, sA);
    if (t + 2 < nkt) ATT_STK(0)
    if (t + 1 < nkt) ATT_STV(1)
    if (t + 3 < nkt) ATT_LDK(t + 3)
    if (t + 2 < nkt) ATT_LDV(t + 2)
    __syncthreads();
    if (t + 1 >= nkt) break;
    if (t + 2 < nkt) qk(0, sA);
    softmax_pv(1, sB);
    if (t + 3 < nkt) ATT_STK(1)
    if (t + 2 < nkt) ATT_STV(0)
    if (t + 4 < nkt) ATT_LDK(t + 4)
    if (t + 3 < nkt) ATT_LDV(t + 3)
    __syncthreads();
  }
#undef ATT_LDK
#undef ATT_LDV
#undef ATT_STK
#undef ATT_STV
#pragma unroll
  for (int qb = 0; qb < 2; ++qb) {
    float lt = l_run[qb];
    lt = xsum16(lt);
    lt = xsum32(lt);
    const float inv = 1.f / lt;
    const int t = q_t0 + wave * 32 + qb * 16 + l15;
#pragma unroll
    for (int db = 0; db < 4; ++db)
      *reinterpret_cast<uint2*>(ATT + (size_t)t * 512 + h * 64 + db * 16 + quad * 4) =
          make_uint2(pack2(oacc[qb][db][0] * inv, oacc[qb][db][1] * inv), pack2(oacc[qb][db][2] * inv, oacc[qb][db][3] * inv));
  }
}

DEV void phase_attn(const Params& p, int l, char* smem) {
  const int c = bidx();
  const int x = c & 7, j = c >> 3;
  int first, cnt;
  if (j < 16) { first = j * 3; cnt = 3; } else { first = 48 + (j - 16) * 5; cnt = 5; }
  for (int i = 0; i < cnt; ++i) {
    const int it = x * 128 + first + i;
    const int b = it >> 7, h = (it >> 4) & 7, qb = it & 15;
    attn_item(p, b, h, b * 4096 + qb * 256, NKEY / 64, smem);
  }
  if (l == 0 && j < 8) {
    const int it = x * 8 + j;
    const int b = it >> 3, h = it & 7;
    attn_item(p, b, h, NXTOK + b * 256, 4, smem);
  }
}

DEV void phase_i(const Params& p, int l, int ntok, char* smem) {
  const int tid = tidx(), lane = tid & 63, wave = tid >> 6;
  const int quad = lane >> 4, l15 = lane & 15;
  const bf16_t* PQ = p.S1;
  float* SV = sv_ptr(p);
  unsigned char* SI = si_ptr(p);
  const int chunk = ntok / 16;
  const int ngrp = chunk / 16;
  for (int task = bidx(); task < 256; task += gdim()) {
    const int hp = task >> 4, ck = task & 15;
    __syncthreads();
    {
      const bf16_t* kp = p.KEYS + ((size_t)l * 16 + hp) * 128 * 128;
#pragma unroll
      for (int q = 0; q < 4; ++q) {
        const int id = tid + q * 512;
        const int r = id >> 4, c = id & 15;
        uint4 v = *reinterpret_cast<const uint4*>(kp + (size_t)r * 128 + c * 8);
        *reinterpret_cast<uint4*>(smem + r * 256 + ((c ^ (r & 15)) << 4)) = v;
      }
    }
    __syncthreads();
    bf16x8 qn[4];
    if (wave < ngrp) {
      const int t1 = ck * chunk + wave * 16 + l15;
#pragma unroll
      for (int s2 = 0; s2 < 4; ++s2)
        qn[s2] = *reinterpret_cast<const bf16x8*>(PQ + (size_t)t1 * 2048 + hp * 128 + s2 * 32 + quad * 8);
    }
    for (int gi = wave; gi < ngrp; gi += NWAVE) {
      const int t = ck * chunk + gi * 16 + l15;
      bf16x8 qf[4];
#pragma unroll
      for (int s2 = 0; s2 < 4; ++s2) qf[s2] = qn[s2];
      if (gi + NWAVE < ngrp) {
        const int t2 = t + NWAVE * 16;
#pragma unroll
        for (int s2 = 0; s2 < 4; ++s2)
          qn[s2] = *reinterpret_cast<const bf16x8*>(PQ + (size_t)t2 * 2048 + hp * 128 + s2 * 32 + quad * 8);
      }
      f32x4 sc[8];
#pragma unroll
      for (int kb = 0; kb < 8; ++kb) {
        sc[kb] = f32x4{0.f, 0.f, 0.f, 0.f};
#pragma unroll
        for (int s2 = 0; s2 < 4; ++s2) {
          const int row = kb * 16 + l15, c = s2 * 4 + quad;
          bf16x8 a = *reinterpret_cast<const bf16x8*>(smem + row * 256 + ((c ^ l15) << 4));
          sc[kb] = __builtin_amdgcn_mfma_f32_16x16x32_bf16(a, qf[s2], sc[kb], 0, 0, 0);
        }
      }
      unsigned key[32];
#pragma unroll
      for (int kb = 0; kb < 8; ++kb)
#pragma unroll
        for (int j = 0; j < 4; ++j) {
          unsigned u = orderable(sc[kb][j]);
          int kidx = kb * 16 + quad * 4 + j;
          key[kb * 4 + j] = (u & ~127u) | (unsigned)(127 - kidx);
        }
#pragma unroll
      for (int k = 2; k <= 32; k <<= 1)
#pragma unroll
        for (int j = k >> 1; j > 0; j >>= 1)
#pragma unroll
          for (int i = 0; i < 32; ++i) {
            const int pr = i ^ j;
            if (pr > i) {
              const unsigned a = key[i], b2 = key[pr];
              const unsigned hi = a > b2 ? a : b2, lo = a > b2 ? b2 : a;
              const bool desc = ((i & k) == 0);
              key[i] = desc ? hi : lo;
              key[pr] = desc ? lo : hi;
            }
          }
      float* svp = SV + ((size_t)t * 16 + hp) * 16;
      unsigned out4[4] = {0u, 0u, 0u, 0u};
#pragma unroll
      for (int r = 0; r < 16; ++r) {
        unsigned m = key[0];
        m = xmaxu16(m);
        m = xmaxu32(m);
        const bool take = (key[0] == m);
#pragma unroll
        for (int i = 0; i < 15 - r; ++i) key[i] = take ? key[i + 1] : key[i];
        key[15 - r] = take ? 0u : key[15 - r];
        out4[r & 3] = (quad == (r >> 2)) ? m : out4[r & 3];
      }
      *reinterpret_cast<uint4*>(reinterpret_cast<unsigned*>(svp) + 4 * quad) = make_uint4(out4[0], out4[1], out4[2], out4[3]);
    }
  }
}

DEV float gelu_tanh(float a) {
  float u = 0.7978845608028654f * (a + 0.044715f * a * a * a);
  float e = __expf(2.f * u);
  float th = 1.f - 2.f / (e + 1.f);
  return 0.5f * a * (1.f + th);
}

template <bool DRY>
DEV void phase_j(const Params& p, int l, int ntok, bool last, char* smem) {
  const int lane = tidx() & 63, wave = tidx() >> 6;
  const int gw = bidx() * NWAVE + wave, nw = gdim() * NWAVE;
  const float* SV = sv_ptr(p);
  const unsigned char* SI = si_ptr(p);
  int* eidx_s = reinterpret_cast<int*>(smem) + wave * 128;
  float* gate_s = reinterpret_cast<float*>(smem + 4096) + wave * 128;
  float* sd_s = reinterpret_cast<float*>(smem + 8192) + wave * 128;
  int ca = -1, cb = 0;
  {
    int cnt = 0;
#pragma unroll
    for (int a = 0; a < 16; ++a) {
      int nb = 16 / (a + 1);
      if (lane >= cnt && lane < cnt + nb) { ca = a; cb = lane - cnt; }
      cnt += nb;
    }
  }
  const bool valid = ca >= 0;
  const int ca_ = valid ? ca : 0;
  for (int t = gw; t < ntok; t += nw) {
    {
      float s0v[8], s1v[8];
      int i0v[8], i1v[8];
      unsigned* svl = reinterpret_cast<unsigned*>(smem + 16384) + wave * 256;
      {
        const uint4 blk = *reinterpret_cast<const uint4*>(reinterpret_cast<const unsigned*>(SV) + (size_t)t * 256 + lane * 4);
        *reinterpret_cast<uint4*>(svl + lane * 4) = blk;
        asm volatile("s_waitcnt lgkmcnt(0)" ::: "memory");
      }
#pragma unroll
      for (int h = 0; h < 8; ++h) {
        const unsigned m0 = svl[(h * 2) * 16 + ca_], m1 = svl[(h * 2 + 1) * 16 + cb];
        s0v[h] = unorderable((m0 & ~127u) | 64u); s1v[h] = unorderable((m1 & ~127u) | 64u);
        i0v[h] = 127 - (int)(m0 & 127u); i1v[h] = 127 - (int)(m1 & 127u);
      }
#pragma unroll
      for (int h = 0; h < 8; ++h) {
        const float scv = s0v[h] + s1v[h];
        const unsigned key = valid ? ((orderable(scv) & ~63u) | (unsigned)(63 - lane)) : 0u;
        int rank = 0;
#pragma unroll
        for (int i = 0; i < 50; ++i) {
          const unsigned ki = (unsigned)__builtin_amdgcn_readlane((int)key, i);
          rank += (ki > key) ? 1 : 0;
        }
        const bool sel = valid && rank < 16;
        const float smax = __builtin_bit_cast(float, __builtin_amdgcn_readlane(__builtin_bit_cast(int, scv), 0));
        const float e = sel ? __expf(scv - smax) : 0.f;
        const float es = wave_sum(e);
        if (sel) {
          const int ex = i0v[h] * 128 + i1v[h];
          eidx_s[h * 16 + rank] = ex;
          gate_s[h * 16 + rank] = (e / es) * p.SU[l * 16384 + ex];
          sd_s[h * 16 + rank] = p.SD[l * 16384 + ex];
        }
      }
    }
    asm volatile("s_waitcnt lgkmcnt(0)" ::: "memory");
    const bf16_t* hrow = p.H + (size_t)t * 1024 + lane * 16;
    f32x2 hf2[8];
    {
      uint4 hv0 = *reinterpret_cast<const uint4*>(hrow);
      uint4 hv1 = *reinterpret_cast<const uint4*>(hrow + 8);
      unsigned hw[8] = {hv0.x, hv0.y, hv0.z, hv0.w, hv1.x, hv1.y, hv1.z, hv1.w};
#pragma unroll
      for (int q = 0; q < 8; ++q) hf2[q] = f32x2{bflo(hw[q]), bfhi(hw[q])};
    }
    f32x2 acc2[8];
#pragma unroll
    for (int i = 0; i < 8; ++i) acc2[i] = f32x2{0.f, 0.f};
    const auto rsD = __builtin_amdgcn_make_buffer_rsrc((void*)(p.PD8 + (size_t)l * 16384 * 512), 0, 16384 * 512, 0x00020000);
    const auto rsU = __builtin_amdgcn_make_buffer_rsrc((void*)(p.PU8 + (size_t)l * 16384 * 512), 0, 16384 * 512, 0x00020000);
    uint2 dA[8], uA[8], dB[8], uB[8];
#define PEER_LOAD(D, U, KB)                                                                \
  _Pragma("unroll") for (int i = 0; i < 8; ++i) {                                          \
    const int e = __builtin_amdgcn_readfirstlane(eidx_s[(KB) * 8 + i]);     \
    D[i] = __builtin_bit_cast(uint2, __builtin_amdgcn_raw_buffer_load_b64(rsD, lane * 8, e * 512, 0)); \
    U[i] = __builtin_bit_cast(uint2, __builtin_amdgcn_raw_buffer_load_b64(rsU, lane * 8, e * 512, 0)); \
  }
#define PEER_COMP(D, U, KB)                                                                \
  {                                                                                        \
    float dots[8];                                                                         \
    _Pragma("unroll") for (int i = 0; i < 8; ++i) {                                        \
      unsigned dw[2] = {D[i].x, D[i].y};                                                   \
      f32x2 d2 = f32x2{0.f, 0.f};                                                          \
      _Pragma("unroll") for (int q = 0; q < 2; ++q) {                                      \
        d2 = hf2[4 * q + 0] * __builtin_amdgcn_cvt_scalef32_pk_f32_fp4(dw[q], 1.0f, 0) + d2; \
        d2 = hf2[4 * q + 1] * __builtin_amdgcn_cvt_scalef32_pk_f32_fp4(dw[q], 1.0f, 1) + d2; \
        d2 = hf2[4 * q + 2] * __builtin_amdgcn_cvt_scalef32_pk_f32_fp4(dw[q], 1.0f, 2) + d2; \
        d2 = hf2[4 * q + 3] * __builtin_amdgcn_cvt_scalef32_pk_f32_fp4(dw[q], 1.0f, 3) + d2; \
      }                                                                                    \
      dots[i] = wave_sum(d2[0] + d2[1]);                                                   \
    }                                                                                      \
    float mine = dots[0];                                                                  \
    _Pragma("unroll") for (int i = 1; i < 8; ++i) mine = ((lane & 7) == i) ? dots[i] : mine; \
    const float av = gate_s[(KB) * 8 + (lane & 7)] * gelu_tanh(mine * sd_s[(KB) * 8 + (lane & 7)]); \
    _Pragma("unroll") for (int i = 0; i < 8; ++i) {                                        \
      const float act = __builtin_bit_cast(float, __builtin_amdgcn_readlane(__builtin_bit_cast(int, av), i)); \
      const f32x2 act2 = f32x2{act, act};                                                  \
      unsigned uw[2] = {U[i].x, U[i].y};                                                   \
      _Pragma("unroll") for (int q = 0; q < 2; ++q) {                                      \
        acc2[4 * q + 0] = act2 * __builtin_amdgcn_cvt_scalef32_pk_f32_fp4(uw[q], 1.0f, 0) + acc2[4 * q + 0]; \
        acc2[4 * q + 1] = act2 * __builtin_amdgcn_cvt_scalef32_pk_f32_fp4(uw[q], 1.0f, 1) + acc2[4 * q + 1]; \
        acc2[4 * q + 2] = act2 * __builtin_amdgcn_cvt_scalef32_pk_f32_fp4(uw[q], 1.0f, 2) + acc2[4 * q + 2]; \
        acc2[4 * q + 3] = act2 * __builtin_amdgcn_cvt_scalef32_pk_f32_fp4(uw[q], 1.0f, 3) + acc2[4 * q + 3]; \
      }                                                                                    \
    }                                                                                      \
  }
    PEER_LOAD(dA, uA, 0)
#pragma unroll 1
    for (int kb = 0; kb < 16; kb += 2) {
      PEER_LOAD(dB, uB, kb + 1)
      PEER_COMP(dA, uA, kb)
      if (kb + 2 < 16) { PEER_LOAD(dA, uA, kb + 2) }
      PEER_COMP(dB, uB, kb + 1)
    }
#undef PEER_LOAD
#undef PEER_COMP
    int lane_r = lane, t_r = t;
    asm volatile("" : "+v"(lane_r), "+v"(t_r));
    const int mr = t_r < NXTOK ? (t_r >> 12) : 8;
    const float* g2 = p.MOD + ((size_t)l * 9 + mr) * 6144 + 5 * 1024 + lane_r * 16;
    float* xr = xrow(p, t_r) + lane_r * 16;
    float xn[16];
    float ss = 0.f;
#pragma unroll
    for (int q4 = 0; q4 < 4; ++q4) {
      float4 xv = *reinterpret_cast<const float4*>(xr + q4 * 4);
      float4 gv = *reinterpret_cast<const float4*>(g2 + q4 * 4);
      const int a0 = q4 * 4;
      xn[a0 + 0] = xv.x + gv.x * acc2[2 * q4][0];
      xn[a0 + 1] = xv.y + gv.y * acc2[2 * q4][1];
      xn[a0 + 2] = xv.z + gv.z * acc2[2 * q4 + 1][0];
      xn[a0 + 3] = xv.w + gv.w * acc2[2 * q4 + 1][1];
      ss += xn[a0] * xn[a0] + xn[a0 + 1] * xn[a0 + 1] + xn[a0 + 2] * xn[a0 + 2] + xn[a0 + 3] * xn[a0 + 3];
    }
    float rs = 1.f;
    if (last) {
      ss = wave_sum(ss);
      rs = rsqrtf(ss * (1.f / 1024.f) + 1e-6f);
    }
#pragma unroll
    for (int q4 = 0; q4 < 4; ++q4) {
      const int a0 = q4 * 4;
      float4 o = make_float4(xn[a0], xn[a0 + 1], xn[a0 + 2], xn[a0 + 3]);
      if (last) {
        float4 fg = *reinterpret_cast<const float4*>(p.final_g + lane_r * 16 + q4 * 4);
        o.x *= rs * fg.x; o.y *= rs * fg.y; o.z *= rs * fg.z; o.w *= rs * fg.w;
      }
      if (!DRY || o.x == 1.2345e33f) *reinterpret_cast<float4*>(xr + q4 * 4) = o;
    }
    if (!last) {
      const float rs1 = rsqrtf(wave_sum(ss) * (1.f / 1024.f) + 1e-6f);
      const float* g1 = p.norm1_g + (l + 1) * 1024 + lane_r * 16;
      const float* md = p.MOD + ((size_t)(l + 1) * 9 + mr) * 6144 + lane_r * 16;
      unsigned hw2[8];
#pragma unroll
      for (int q4 = 0; q4 < 4; ++q4) {
        const float4 gg = *reinterpret_cast<const float4*>(g1 + q4 * 4);
        const float4 sh = *reinterpret_cast<const float4*>(md + q4 * 4);
        const float4 sc = *reinterpret_cast<const float4*>(md + 1024 + q4 * 4);
        const int a0 = q4 * 4;
        const float h0 = xn[a0] * rs1 * gg.x * (1.f + sc.x) + sh.x;
        const float h1 = xn[a0 + 1] * rs1 * gg.y * (1.f + sc.y) + sh.y;
        const float h2 = xn[a0 + 2] * rs1 * gg.z * (1.f + sc.z) + sh.z;
        const float h3 = xn[a0 + 3] * rs1 * gg.w * (1.f + sc.w) + sh.w;
        hw2[2 * q4] = pack2(h0, h1); hw2[2 * q4 + 1] = pack2(h2, h3);
      }
      bf16_t* hdst = p.H + (size_t)t_r * 1024 + lane_r * 16;
      *reinterpret_cast<uint4*>(hdst) = make_uint4(hw2[0], hw2[1], hw2[2], hw2[3]);
      *reinterpret_cast<uint4*>(hdst + 8) = make_uint4(hw2[4], hw2[5], hw2[6], hw2[7]);
    }
    asm volatile("s_waitcnt lgkmcnt(0)" ::: "memory");
  }
}

__global__ void __launch_bounds__(512, 2) mega_kernel(Params p) {
  __shared__ __attribute__((aligned(16))) char smem[SMEM_BYTES + 16];
  cg::grid_group grid = cg::this_grid();
  if (threadIdx.x == 0) *reinterpret_cast<uint4*>(smem + SMEM_BYTES) = make_uint4(0u, 0u, 0u, 0u);
  __syncthreads();
  XcdBarrier xb = xcd_barrier_post(p.BAR, reinterpret_cast<volatile unsigned*>(smem + SMEM_BYTES));
  phase_prep(p, smem);
  xcd_barrier(xb);
#pragma unroll 1
  for (int l = 0; l < 2; ++l) {
    const bool last = (l == 1);
    const int ntok = last ? NXTOK : NTOK;
    const int ntt = ntok / 128;
#pragma unroll 1
    for (int st = 0; st < 18; ++st) {
      bool is_gemm = false, bar = true;
      g8::Gemm g{nullptr, nullptr, 0, 0, 0};
      g8::Order S{1, 0, gdim(), -1};
      g8::EpiAny E{0, nullptr, nullptr, nullptr, nullptr, nullptr, 0, 0, 0.f};
      const int G = gdim(), cb = bidx();
      const int cr = xcd_remap(cb, G);
      bf16_t* YF = p.S1 + (size_t)NTOK * 512;
      bf16_t* MERGED = p.R2;
      bf16_t* TMPG = p.R2 + (size_t)NTOK * 1024;
      switch (st) {
        case 0: if (l == 0) phase_ln(p, l, p.norm1_g + l * 1024, 0, NTOK, true); else bar = false; break;
        case 1:
          g = g8::Gemm{p.H, p.WinT + (size_t)l * 4096 * 1024, 1024, 1024, 1024};
          S = g8::Order{4, (NTOK / 256) * 4, G, cr};
          E.kind = 0; E.p0 = p.S1; E.i0 = 1024; is_gemm = true; break;
        case 2: phase_c1(p, l); break;
        case 3: phase_c2(p, l, ntt, smem); break;
        case 4:
          g = g8::Gemm{p.A2, p.UTx, 8192, 8192, 8192};
          S = g8::Order{8, 128, G, (cb >> 3) < 16 ? (cb & 7) * 16 + (cb >> 3) : -1};
          E.kind = 1; E.p0 = YF; E.i0 = 0; E.i1 = 4096; E.f0 = 1.f / 1024.f; is_gemm = true; bar = false; break;
        case 5:
          if (l == 0) {
            g = g8::Gemm{p.A2c, p.UTc, 512, 512, 512};
            S = g8::Order{8, 8, G, (cb >> 3) == 8 ? (cb & 7) : -1};
            E.kind = 1; E.p0 = YF; E.i0 = NXTOK; E.i1 = 256; E.f0 = 1.f / 256.f; is_gemm = true;
          }
          bar = false; break;
        case 6: phase_attn(p, l, smem); break;
        case 7: case 9: case 11: {
          const int br = (st - 7) >> 1;
          g = g8::Gemm{p.H, p.WinT + ((size_t)l * 4096 + 1024 + br * 1024) * 1024, 1024, 1024, 1024};
          S = g8::Order{4, (ntok / 256) * 4, G, cr};
          E.kind = 2; E.p0 = TMPG; E.p1 = p.b_gate + (size_t)l * 3072 + br * 1024; is_gemm = true; bar = false; break;
        }
        case 8: case 10: case 12: {
          const int br = (st - 8) >> 1;
          const bf16_t* Ab; const bf16_t* Wb; int Kb_;
          if (br == 0) { Ab = p.S1; Wb = p.WoaT + (size_t)l * 1024 * 512; Kb_ = 512; }
          else if (br == 1) { Ab = YF; Wb = p.WobT + (size_t)l * 1024 * 256; Kb_ = 256; }
          else { Ab = p.POOLED; Wb = p.WpcT + (size_t)l * 1024 * 256; Kb_ = 256; }
          g = g8::Gemm{Ab, Wb, Kb_, Kb_, Kb_};
          S = g8::Order{4, (ntok / 256) * 4, G, cr};
          E.kind = 3; E.p0 = TMPG; E.p1 = MERGED; E.i0 = (br == 0) ? 1 : 0; is_gemm = true; bar = (st == 12); break;
        }
        case 13:
          g = g8::Gemm{MERGED, p.WoutT + (size_t)l * 1024 * 1024, 1024, 1024, 1024};
          S = g8::Order{4, (ntok / 256) * 4, G, cr};
          E.kind = 4; E.p0 = p.out; E.p1 = p.Xc; E.p2 = p.MOD + (size_t)l * 9 * 6144 + 2 * 1024;
          E.p3 = (l == 0) ? p.x : p.out; E.p4 = (l == 0) ? p.ctx : p.Xc; is_gemm = true; break;
        case 14: phase_ln(p, l, p.norm2_g + l * 1024, 3, ntok, false); break;
        case 15:
          g = g8::Gemm{p.H, p.WpqT + (size_t)l * 2048 * 1024, 1024, 1024, 1024};
          S = g8::Order{8, (ntok / 256) * 8, G, cr};
          E.kind = 0; E.p0 = p.S1; E.i0 = 2048; is_gemm = true; break;
        case 16: phase_i(p, l, ntok, smem); break;
        default: phase_j<false>(p, l, ntok, last, smem); bar = !last; break;
      }
      if (is_gemm) g8::gemm_phase((LAS unsigned char*)(smem), g, S, E);
      if (bar) xcd_barrier(xb);
    }
  }
  grid.sync();
}

extern "C" void kernel_launch(void* const* d_in, const int* in_sizes, int n_in, void* d_out, int out_size, void* d_ws,
                              size_t ws_size, hipStream_t stream) {
  Params p{};
  const float** fp = reinterpret_cast<const float**>(&p);
  for (int i = 0; i < 25; ++i) fp[i] = reinterpret_cast<const float*>(d_in[i]);
  p.out = reinterpret_cast<float*>(d_out);
  char* w = reinterpret_cast<char*>(d_ws);
  size_t off = 0;
  auto take = [&](size_t bytes) { char* r = w + off; off += (bytes + 255) & ~(size_t)255; return r; };
  p.Xc = (float*)take((size_t)2048 * 1024 * 4);
  p.H = (bf16_t*)take((size_t)NTOK * 1024 * 2);
  p.S1 = (bf16_t*)take((size_t)NTOK * 1024 * 2);
  p.UTx = (bf16_t*)take((size_t)8 * 256 * 8192 * 2);
  p.UTc = (bf16_t*)take((size_t)8 * 256 * 512 * 2);
  p.POOLED = (bf16_t*)take((size_t)NTOK * 256 * 2);
  p.R2 = (bf16_t*)take((size_t)NTOK * 768 * 2 + (size_t)64 * NKEY * 96 * 2 + (size_t)64 * 64 * NKEY * 2);
  p.WinT = (bf16_t*)take((size_t)2 * 4096 * 1024 * 2);
  p.WuqT = (bf16_t*)take((size_t)2 * 768 * 256 * 2);
  p.WukvT = (bf16_t*)take((size_t)2 * 1024 * 128 * 2);
  p.WoaT = (bf16_t*)take((size_t)2 * 1024 * 512 * 2);
  p.WobT = (bf16_t*)take((size_t)2 * 1024 * 256 * 2);
  p.WpcT = (bf16_t*)take((size_t)2 * 1024 * 256 * 2);
  p.WoutT = (bf16_t*)take((size_t)2 * 1024 * 1024 * 2);
  p.WpqT = (bf16_t*)take((size_t)2 * 2048 * 1024 * 2);
  p.KEYS = (bf16_t*)take((size_t)2 * 16 * 128 * 128 * 2);
  p.PD8 = (unsigned char*)take((size_t)2 * 16384 * 1024);
  p.PU8 = (unsigned char*)take((size_t)2 * 16384 * 1024);
  p.SD = (float*)take((size_t)2 * 16384 * 4);
  p.SU = (float*)take((size_t)2 * 16384 * 4);
  p.BAR = (unsigned*)take((size_t)XCD_BAR_WORDS * 4);
  p.ROPE = (float*)take((size_t)64 * 8 * 2 * 4);
  p.A2 = (bf16_t*)take((size_t)4096 * 8192 * 2);
  p.A2c = (bf16_t*)take((size_t)256 * 512 * 2);
  p.CS = (bf16_t*)take((size_t)512 * 256 * 2);
  p.MOD = (float*)take((size_t)2 * 9 * 6144 * 4);
  if (off > ws_size) fprintf(stderr, "workspace too small: need %zu have %zu\n", off, ws_size);

  static int grid_blocks = 0;
  if (!grid_blocks) {
    int dev = 0, cus = 0, per_cu = 0;
    (void)hipGetDevice(&dev);
    (void)hipDeviceGetAttribute(&cus, hipDeviceAttributeMultiprocessorCount, dev);
    (void)hipOccupancyMaxActiveBlocksPerMultiprocessor(&per_cu, mega_kernel, NTHR, 0);
    if (per_cu > 1) per_cu = 1;
    if (per_cu < 1) per_cu = 1;
    grid_blocks = cus * per_cu;
  }
  (void)hipMemsetAsync(p.BAR, 0, (size_t)XCD_BAR_WORDS * 4, stream);
  void* args[] = {&p};
  hipError_t e = hipLaunchCooperativeKernel((void*)mega_kernel, dim3(grid_blocks), dim3(NTHR), args, 0, stream);
  if (e != hipSuccess) fprintf(stderr, "cooperative launch failed: %s (grid %d)\n", hipGetErrorString(e), grid_blocks);
}
```

```cpp
#include <hip/hip_runtime.h>
#include <hip/hip_cooperative_groups.h>
#include <cstdio>
#include <cstdint>
namespace cg = cooperative_groups;

typedef unsigned short bf16_t;
typedef __attribute__((ext_vector_type(8))) short bf16x8;
typedef __attribute__((ext_vector_type(4))) float f32x4;
typedef __attribute__((ext_vector_type(2))) __bf16 bf2_t;
typedef __attribute__((ext_vector_type(2))) float f32x2;

#define DEV __device__ __forceinline__
DEV int tidx() { int v = threadIdx.x; asm volatile("" : "+v"(v)); return v; }
DEV int bidx() { int v = blockIdx.x; asm volatile("" : "+s"(v)); return v; }
DEV int gdim() { int v = gridDim.x; asm volatile("" : "+s"(v)); return v; }

constexpr int NTOK = 34816;
constexpr int NXTOK = 32768;
constexpr int NKEY = 4352;
constexpr int SMEM_BYTES = 131072;
constexpr int NTHR = 512, NWAVE = 8;
#define LAS __attribute__((address_space(3)))

struct Params {
  const float *x, *c, *ctx, *c_ctx, *w_mod, *b_mod, *norm1_g, *norm2_g, *w_in, *b_gate, *q_norm_g, *w_uq,
      *kv_norm_g, *w_ukv, *w_oa, *w_ob, *w_grp, *pool_scale, *w_oc, *w_out, *w_pq, *peer_keys, *peer_down,
      *peer_up, *final_g;
  float* out;
  float* Xc;
  bf16_t *H, *S1, *UTx, *UTc, *POOLED, *R2;
  bf16_t *WinT, *WuqT, *WukvT, *WoaT, *WobT, *WpcT, *WoutT, *WpqT, *KEYS, *A2, *A2c, *CS;
  float* MOD;
  unsigned char *PD8, *PU8;
  float *SD, *SU;
  unsigned* BAR;
  float* ROPE;
};

DEV bf16_t f2bf(float f) {
  unsigned u = __float_as_uint(f);
  u += 0x7fffu + ((u >> 16) & 1u);
  return (bf16_t)(u >> 16);
}
DEV float bf2f(bf16_t h) { return __uint_as_float(((unsigned)h) << 16); }
DEV unsigned pack2(float a, float b) { unsigned r; asm("v_cvt_pk_bf16_f32 %0, %1, %2" : "=v"(r) : "v"(a), "v"(b)); return r; }
DEV float bflo(unsigned u) { return __uint_as_float(u << 16); }
DEV float bfhi(unsigned u) { return __uint_as_float(u & 0xffff0000u); }
template <int CTRL, int RMASK>
DEV float dpp_f(float v) {
  return __builtin_bit_cast(float, __builtin_amdgcn_update_dpp(0, __builtin_bit_cast(int, v), CTRL, RMASK, 0xF, false));
}
DEV float wave_sum(float v) {
  v += dpp_f<0xB1, 0xF>(v);
  v += dpp_f<0x4E, 0xF>(v);
  v += dpp_f<0x141, 0xF>(v);
  v += dpp_f<0x140, 0xF>(v);
  v += dpp_f<0x142, 0xA>(v);
  v += dpp_f<0x143, 0xC>(v);
  return __builtin_bit_cast(float, __builtin_amdgcn_readlane(__builtin_bit_cast(int, v), 63));
}
DEV unsigned wave_max_u(unsigned v) {
#pragma unroll
  for (int o = 32; o > 0; o >>= 1) {
    unsigned w = (unsigned)__shfl_xor((int)v, o);
    v = v > w ? v : w;
  }
  return v;
}
DEV float xmax16(float v) { auto r = __builtin_amdgcn_permlane16_swap(__builtin_bit_cast(unsigned, v), __builtin_bit_cast(unsigned, v), false, false);
  return fmaxf(__builtin_bit_cast(float, r[0]), __builtin_bit_cast(float, r[1])); }
DEV float xmax32(float v) { auto r = __builtin_amdgcn_permlane32_swap(__builtin_bit_cast(unsigned, v), __builtin_bit_cast(unsigned, v), false, false);
  return fmaxf(__builtin_bit_cast(float, r[0]), __builtin_bit_cast(float, r[1])); }
DEV float xsum16(float v) { auto r = __builtin_amdgcn_permlane16_swap(__builtin_bit_cast(unsigned, v), __builtin_bit_cast(unsigned, v), false, false);
  return __builtin_bit_cast(float, r[0]) + __builtin_bit_cast(float, r[1]); }
DEV float xsum32(float v) { auto r = __builtin_amdgcn_permlane32_swap(__builtin_bit_cast(unsigned, v), __builtin_bit_cast(unsigned, v), false, false);
  return __builtin_bit_cast(float, r[0]) + __builtin_bit_cast(float, r[1]); }
DEV float wave_max_f(float v) {
  v = fmaxf(v, dpp_f<0xB1, 0xF>(v)); v = fmaxf(v, dpp_f<0x4E, 0xF>(v));
  v = fmaxf(v, dpp_f<0x141, 0xF>(v)); v = fmaxf(v, dpp_f<0x140, 0xF>(v));
  v = xmax16(v); v = xmax32(v); return v; }
DEV unsigned xmaxu16(unsigned v) { auto r = __builtin_amdgcn_permlane16_swap(v, v, false, false); return r[0] > r[1] ? r[0] : r[1]; }
DEV unsigned xmaxu32(unsigned v) { auto r = __builtin_amdgcn_permlane32_swap(v, v, false, false); return r[0] > r[1] ? r[0] : r[1]; }
DEV int xcd_remap(int c, int G) { return (c & 7) * (G >> 3) + (c >> 3); }
DEV unsigned orderable(float f) {
  unsigned u = __float_as_uint(f);
  return (u & 0x80000000u) ? ~u : (u | 0x80000000u);
}
DEV float unorderable(unsigned u) {
  return __uint_as_float((u & 0x80000000u) ? (u ^ 0x80000000u) : ~u);
}
DEV float* sv_ptr(const Params& p) { return reinterpret_cast<float*>(reinterpret_cast<char*>(p.R2) + ((size_t)64 << 20)); }
DEV unsigned char* si_ptr(const Params& p) { return reinterpret_cast<unsigned char*>(sv_ptr(p) + (size_t)NTOK * 256); }
DEV float* xrow(const Params& p, int t) {
  return t < NXTOK ? p.out + (size_t)t * 1024 : p.Xc + (size_t)(t - NXTOK) * 1024;
}
DEV bf16x8 mk8(uint2 lo, uint2 hi) {
  uint4 v = make_uint4(lo.x, lo.y, hi.x, hi.y);
  return __builtin_bit_cast(bf16x8, v);
}
DEV bf16x8 pack8(const f32x4& a, const f32x4& b) {
  uint4 v = make_uint4(pack2(a[0], a[1]), pack2(a[2], a[3]), pack2(b[0], b[1]), pack2(b[2], b[3]));
  return __builtin_bit_cast(bf16x8, v);
}


#define XB_TMO      128
#define XB_XCNT(j)  (256  + 64 * (j))
#define XB_XSUB(j)  (1280 + 64 * (j))
#define XB_XGEN(j)  (2304 + 64 * (j))
#define XB_TOP      3328
#define XB_TOPGEN   3392
#define XCD_BAR_WORDS 3456
#define XB_SPIN_CAP (1u << 20)
DEV unsigned xb_ld(unsigned* p) { return __hip_atomic_load(p, __ATOMIC_RELAXED, __HIP_MEMORY_SCOPE_AGENT); }
DEV unsigned xb_add(unsigned* p, unsigned v) { return __hip_atomic_fetch_add(p, v, __ATOMIC_RELAXED, __HIP_MEMORY_SCOPE_AGENT); }
DEV unsigned xb_xcc_id() { return (unsigned)__builtin_amdgcn_s_getreg((3 << 11) | 20) & 0xFu; }
#define XB_SPIN(cond, bar) do { unsigned _sp = 0; while (cond) { __builtin_amdgcn_s_sleep(1); \
    if ((++_sp & 255u) == 0u) { if (xb_ld(&(bar)[XB_TMO])) break; if (_sp > XB_SPIN_CAP) { atomicAdd(&(bar)[XB_TMO], 1u); break; } } } } while (0)

struct XcdBarrier { unsigned* bar; unsigned x; volatile unsigned* st; };

DEV XcdBarrier xcd_barrier_post(unsigned* bar, volatile unsigned* st) {
  XcdBarrier b; b.bar = bar; b.x = xb_xcc_id(); b.st = st;
  if (threadIdx.x == 0) (void)xb_add(&bar[XB_XCNT(b.x)], 1u);
  return b;
}
DEV void xcd_barrier_complete(unsigned* bar, unsigned x, unsigned& nloc, unsigned& nx) {
  const unsigned G = gridDim.x;
  unsigned sum, cnt, mine, sp = 0u;
  for (;;) {
    sum = 0u; cnt = 0u; mine = 0u;
#pragma unroll
    for (unsigned j = 0; j < 16; ++j) { const unsigned c = xb_ld(&bar[XB_XCNT(j)]); sum += c; cnt += (c > 0u) ? 1u : 0u; mine = (j == x) ? c : mine; }
    if (sum == G) break;
    __builtin_amdgcn_s_sleep(1);
    if ((++sp & 255u) == 0u) { if (xb_ld(&bar[XB_TMO])) break; if (sp > XB_SPIN_CAP) { atomicAdd(&bar[XB_TMO], 1u); break; } }
  }
  nloc = mine > 0u ? mine : 1u; nx = cnt > 0u ? cnt : 1u;
}
DEV void xcd_barrier(const XcdBarrier& b) {
  asm volatile("s_waitcnt vmcnt(0)" ::: "memory");
  __syncthreads();
  if (threadIdx.x == 0) {
    unsigned* bar = b.bar;
    __builtin_amdgcn_s_waitcnt(0);
    unsigned nloc = b.st[0], nx = b.st[1];
    if (nloc == 0u) { xcd_barrier_complete(bar, b.x, nloc, nx); b.st[0] = nloc; b.st[1] = nx; }
    const unsigned old = xb_add(&bar[XB_XSUB(b.x)], 1u);
    const unsigned gen = old / nloc;
    if (old + 1u == (gen + 1u) * nloc) {
      __builtin_amdgcn_fence(__ATOMIC_RELEASE, "agent");
      asm volatile("s_waitcnt vmcnt(0)" ::: "memory");
      const unsigned og = xb_add(&bar[XB_TOP], 1u);
      const unsigned tg = og / nx;
      if (og + 1u == (tg + 1u) * nx) xb_add(&bar[XB_TOPGEN], 1u);
      else XB_SPIN(xb_ld(&bar[XB_TOPGEN]) == tg, bar);
      __builtin_amdgcn_fence(__ATOMIC_ACQUIRE, "agent");
      xb_add(&bar[XB_XGEN(b.x)], 1u);
      asm volatile("s_waitcnt vmcnt(0)" ::: "memory");
    } else {
      XB_SPIN(xb_ld(&bar[XB_XGEN(b.x)]) == gen, bar);
      __builtin_amdgcn_fence(__ATOMIC_ACQUIRE, "agent");
      asm volatile("s_waitcnt vmcnt(0)" ::: "memory");
    }
  }
  __syncthreads();
}

template <int WM, int WN>
DEV void gemm_mainloop(const bf16_t* __restrict__ A, long lda, const bf16_t* __restrict__ B, long ldb, int K,
                       f32x4 (&acc)[8 / WM][8 / WN], char* smem) {
  constexpr int MI = 8 / WM, NI = 8 / WN;
  const int tid = tidx(), lane = tid & 63, wave = tid >> 6;
  const int wm = wave / WN, wn = wave % WN;
  const int lrow = tid >> 3, lchunk = tid & 7;
  const bf16_t* ga = A + (long)lrow * lda + lchunk * 8;
  const bf16_t* gb = B + (long)lrow * ldb + lchunk * 8;
  uint4 ra[2], rb[2];
  const int KT = K >> 6;
#pragma unroll
  for (int p = 0; p < 2; ++p) {
    ra[p] = *reinterpret_cast<const uint4*>(ga + (long)(p * 64) * lda);
    rb[p] = *reinterpret_cast<const uint4*>(gb + (long)(p * 64) * ldb);
  }
#pragma unroll
  for (int p = 0; p < 2; ++p) {
    int row = p * 64 + lrow;
    int off = row * 128 + ((lchunk ^ (row & 7)) << 4);
    *reinterpret_cast<uint4*>(smem + off) = ra[p];
    *reinterpret_cast<uint4*>(smem + 16384 + off) = rb[p];
  }
  __syncthreads();
  for (int kt = 0; kt < KT; ++kt) {
    const bool more = (kt + 1 < KT);
    if (more) {
      const int k0 = (kt + 1) << 6;
#pragma unroll
      for (int p = 0; p < 2; ++p) {
        ra[p] = *reinterpret_cast<const uint4*>(ga + (long)(p * 64) * lda + k0);
        rb[p] = *reinterpret_cast<const uint4*>(gb + (long)(p * 64) * ldb + k0);
      }
    }
    {
      const char* sa = smem + (kt & 1) * 32768;
      const char* sb = sa + 16384;
#pragma unroll
      for (int ks = 0; ks < 2; ++ks) {
        bf16x8 af[MI], bfr[NI];
        const int ch = ((ks * 4 + (lane >> 4)) ^ (lane & 7)) << 4;
#pragma unroll
        for (int mi = 0; mi < MI; ++mi) {
          int row = wm * (MI * 16) + mi * 16 + (lane & 15);
          af[mi] = *reinterpret_cast<const bf16x8*>(sa + row * 128 + ch);
        }
#pragma unroll
        for (int ni = 0; ni < NI; ++ni) {
          int row = wn * (NI * 16) + ni * 16 + (lane & 15);
          bfr[ni] = *reinterpret_cast<const bf16x8*>(sb + row * 128 + ch);
        }
#pragma unroll
        for (int mi = 0; mi < MI; ++mi)
#pragma unroll
          for (int ni = 0; ni < NI; ++ni)
            acc[mi][ni] = __builtin_amdgcn_mfma_f32_16x16x32_bf16(af[mi], bfr[ni], acc[mi][ni], 0, 0, 0);
      }
    }
    if (more) {
      char* sa = smem + ((kt + 1) & 1) * 32768;
#pragma unroll
      for (int p = 0; p < 2; ++p) {
        int row = p * 64 + lrow;
        int off = row * 128 + ((lchunk ^ (row & 7)) << 4);
        *reinterpret_cast<uint4*>(sa + off) = ra[p];
        *reinterpret_cast<uint4*>(sa + 16384 + off) = rb[p];
      }
    }
    __syncthreads();
  }
}

template <int MI, int NI>
DEV void zero_acc(f32x4 (&acc)[MI][NI]) {
#pragma unroll
  for (int i = 0; i < MI; ++i)
#pragma unroll
    for (int j = 0; j < NI; ++j) acc[i][j] = f32x4{0.f, 0.f, 0.f, 0.f};
}


namespace g8 {
constexpr int BM = 256, BK = 64, HALF = 128, HTB = HALF * BK * 2;
DEV int lds_byte(int r, int c) { const int st = (r >> 4) * 2 + (c >> 5), rr = r & 15, cc = c & 31, ob = rr * 64 + cc * 2; return st * 1024 + (ob ^ (((ob >> 9) & 1) << 5)); }
DEV void stage_rc(int b, int& R, int& C) { const int st = b / 1024, sb = b % 1024, swz = sb ^ (((sb >> 9) & 1) << 5); R = (st >> 1) * 16 + swz / 64; C = (st & 1) * 32 + (swz % 64) / 2; }
DEV int perm32(int rho) { const int n = rho >> 4, i = rho & 15; return 8 * (i >> 2) + 4 * n + (i & 3); }
struct Unit { int pm, pn; };
struct Gemm { const bf16_t* A; const bf16_t* Bt; int lda, ldb, K; };
struct Order {
  int nN, nunits, G, c;
  DEV bool next(int i, Unit& u) const {
    const int L = i * G + c;
    if (c < 0 || L >= nunits) return false;
    u.pm = L / nN; u.pn = L % nN; return true;
  }
};

template <class Epi>
DEV void gemm_phase(LAS unsigned char* lds, const Gemm g, const Order& S, const Epi& E) {
  const int tid = tidx(), wid = __builtin_amdgcn_readfirstlane(tid >> 6), lane = tid & 63, wr = wid >> 2, wc = wid & 3, fr = lane & 15, fq = lane >> 4;
  const int K = g.K, nt = K / BK;
  unsigned voffA[2], voffB[2];
#pragma unroll
  for (int i = 0; i < 2; ++i) { int R, C; stage_rc(tid * 16 + i * 8192, R, C); const int Rb = Epi::PERM ? ((R & ~31) + perm32(R & 31)) : R;
    voffA[i] = (unsigned)(R * g.lda + C) * 2u; voffB[i] = (unsigned)(Rb * g.ldb + C) * 2u; }
  const size_t kstep = (size_t)(BK * 2);
  const size_t hstepA = (size_t)HALF * g.lda * 2, hstepB = (size_t)HALF * g.ldb * 2;
  const size_t tstepA = 2 * hstepA, tstepB = 2 * hstepB;
  const unsigned ldsw = (unsigned)wid * 1024u;
  const int aoff = lds_byte(wr * 64 + fr, fq * 8), boff = lds_byte(wc * 32 + fr, fq * 8);
#define PG8_SA(b, h) (((b) * 2 + (h)) * HTB)
#define PG8_SB(b, h) ((4 + (b) * 2 + (h)) * HTB)
#define PG8_STAGE(bufoff, gbase, voff) do { _Pragma("unroll") for (int _i = 0; _i < 2; ++_i) \
        __builtin_amdgcn_global_load_lds((const unsigned*)((const char*)(gbase) + (voff)[_i]), (LAS unsigned*)(lds + (bufoff) + ldsw + _i * 8192), 16, 0, 0); } while (0)
#define PG8_LDA(dst, b, h) do { _Pragma("unroll") for (int m = 0; m < 4; ++m) _Pragma("unroll") for (int k = 0; k < 2; ++k) dst[m][k] = *(const LAS bf16x8*)(lds + PG8_SA(b, h) + aoff + m * 2048 + k * 1024); } while (0)
#define PG8_LDB(dst, b, h) do { _Pragma("unroll") for (int n = 0; n < 2; ++n) _Pragma("unroll") for (int k = 0; k < 2; ++k) dst[n][k] = *(const LAS bf16x8*)(lds + PG8_SB(b, h) + boff + n * 2048 + k * 1024); } while (0)
#define PG8_MMA(ai, bj, At, Bt) do { __builtin_amdgcn_s_setprio(1); _Pragma("unroll") for (int m = 0; m < 4; ++m) _Pragma("unroll") for (int n = 0; n < 2; ++n) _Pragma("unroll") for (int k = 0; k < 2; ++k) \
        acc[ai][bj][m][n] = __builtin_amdgcn_mfma_f32_16x16x32_bf16(Bt[n][k], At[m][k], acc[ai][bj][m][n], 0, 0, 0); __builtin_amdgcn_s_setprio(0); } while (0)
#define PG8_WAIT_V(n) asm volatile("s_waitcnt vmcnt(" #n ")" ::: "memory")
#define PG8_WAIT_L(n) asm volatile("s_waitcnt lgkmcnt(" #n ")" ::: "memory")
#define PG8_BAR __builtin_amdgcn_s_barrier()
#define PG8_SCHED __builtin_amdgcn_sched_barrier(0)
  Unit cur, nxt; int ui = 0;
  if (!S.next(0, cur)) return;
  f32x4 acc[2][2][4][2];
#pragma unroll
  for (int a = 0; a < 2; ++a)
#pragma unroll
    for (int b = 0; b < 2; ++b)
#pragma unroll
      for (int m = 0; m < 4; ++m)
#pragma unroll
        for (int n = 0; n < 2; ++n) acc[a][b][m][n] = (f32x4){0.f, 0.f, 0.f, 0.f};
  bf16x8 At[4][2], B0[2][2], B1[2][2];
  const char* cA = (const char*)g.A + (size_t)cur.pm * tstepA; const char* cB = (const char*)g.Bt + (size_t)cur.pn * tstepB;
  PG8_STAGE(PG8_SB(0, 0), cB, voffB); PG8_STAGE(PG8_SA(0, 0), cA, voffA); PG8_STAGE(PG8_SB(0, 1), cB + hstepB, voffB); PG8_STAGE(PG8_SA(0, 1), cA + hstepA, voffA);
  if (wr == 1) PG8_BAR;
  PG8_WAIT_V(4); PG8_BAR;
  PG8_STAGE(PG8_SB(1, 0), cB + kstep, voffB); PG8_STAGE(PG8_SA(1, 0), cA + kstep, voffA); PG8_STAGE(PG8_SB(1, 1), cB + hstepB + kstep, voffB);
  PG8_WAIT_V(6); PG8_BAR;
  for (;;) {
    const bool has_next = S.next(ui + 1, nxt);
    const char* nA = has_next ? (const char*)g.A + (size_t)nxt.pm * tstepA : cA; const char* nB = has_next ? (const char*)g.Bt + (size_t)nxt.pn * tstepB : cB;
    for (int t = 0; t < nt; t += 2) {
      const bool last = (t == nt - 2);
      const char* a1 = cA + (size_t)(t + 1) * kstep;
      const char* a2 = last ? nA : cA + (size_t)(t + 2) * kstep; const char* b2 = last ? nB : cB + (size_t)(t + 2) * kstep;
      const char* a3 = a2 + kstep; const char* b3 = b2 + kstep;
      PG8_LDB(B0, 0, 0); PG8_SCHED; PG8_LDA(At, 0, 0); PG8_STAGE(PG8_SA(1, 1), a1 + hstepA, voffA);
      PG8_WAIT_L(8); PG8_BAR; PG8_WAIT_L(0); PG8_MMA(0, 0, At, B0); PG8_BAR; PG8_SCHED;
      PG8_LDB(B1, 0, 1); PG8_STAGE(PG8_SB(0, 0), b2, voffB);
      PG8_BAR; PG8_WAIT_L(0); PG8_MMA(0, 1, At, B1); PG8_BAR;
      PG8_LDA(At, 0, 1); PG8_STAGE(PG8_SA(0, 0), a2, voffA);
      PG8_BAR; PG8_WAIT_L(0); PG8_MMA(1, 0, At, B0); PG8_BAR; PG8_SCHED;
      PG8_STAGE(PG8_SB(0, 1), b2 + hstepB, voffB);
      PG8_WAIT_V(6); PG8_BAR; PG8_MMA(1, 1, At, B1); PG8_BAR;
      PG8_LDB(B0, 1, 0); PG8_SCHED; PG8_LDA(At, 1, 0); PG8_STAGE(PG8_SA(0, 1), a2 + hstepA, voffA);
      PG8_WAIT_L(8); PG8_BAR; PG8_WAIT_L(0); PG8_MMA(0, 0, At, B0); PG8_BAR; PG8_SCHED;
      PG8_LDB(B1, 1, 1); PG8_STAGE(PG8_SB(1, 0), b3, voffB);
      PG8_BAR; PG8_WAIT_L(0); PG8_MMA(0, 1, At, B1); PG8_BAR;
      PG8_LDA(At, 1, 1); PG8_STAGE(PG8_SA(1, 0), a3, voffA);
      PG8_BAR; PG8_WAIT_L(0); PG8_MMA(1, 0, At, B0); PG8_BAR; PG8_SCHED;
      PG8_STAGE(PG8_SB(1, 1), b3 + hstepB, voffB);
      PG8_WAIT_V(6); PG8_BAR; PG8_MMA(1, 1, At, B1); PG8_BAR;
    }
    E(acc, cur, wr, wc, fr, fq);
    if (!has_next) break;
#pragma unroll
    for (int a = 0; a < 2; ++a)
#pragma unroll
      for (int b = 0; b < 2; ++b)
#pragma unroll
        for (int m = 0; m < 4; ++m)
#pragma unroll
          for (int n = 0; n < 2; ++n) acc[a][b][m][n] = (f32x4){0.f, 0.f, 0.f, 0.f};
    cur = nxt; cA = nA; cB = nB; ++ui;
  }
  PG8_WAIT_V(0);
  if (wr == 0) PG8_BAR;
  PG8_BAR;
#undef PG8_SA
#undef PG8_SB
#undef PG8_STAGE
#undef PG8_LDA
#undef PG8_LDB
#undef PG8_MMA
#undef PG8_WAIT_V
#undef PG8_WAIT_L
#undef PG8_BAR
#undef PG8_SCHED
}

struct EpiStoreBf16 {
  static constexpr bool PERM = true;
  bf16_t* O; int ldc;
  DEV void operator()(const f32x4 (&acc)[2][2][4][2], const Unit& u, int wr, int wc, int fr, int fq) const {
    const int row0 = u.pm * BM + wr * 64 + fr, col0 = u.pn * BM + wc * 32 + 8 * fq;
#pragma unroll
    for (int ai = 0; ai < 2; ++ai)
#pragma unroll
      for (int m = 0; m < 4; ++m) {
        bf16_t* rowp = O + (size_t)(row0 + ai * HALF + m * 16) * ldc + col0;
#pragma unroll
        for (int bj = 0; bj < 2; ++bj) {
          const f32x4 v0 = acc[ai][bj][m][0], v1 = acc[ai][bj][m][1];
          *reinterpret_cast<uint4*>(rowp + bj * HALF) = make_uint4(pack2(v0[0], v0[1]), pack2(v0[2], v0[3]), pack2(v1[0], v1[1]), pack2(v1[2], v1[3]));
        }
      }
  }
};
struct EpiFourier {
  static constexpr bool PERM = true;
  bf16_t* YF; int tok0, L; float scale;
  DEV void operator()(const f32x4 (&acc)[2][2][4][2], const Unit& u, int wr, int wc, int fr, int fq) const {
    const int row0 = u.pm * BM + wr * 64 + fr, col0 = wc * 32 + 8 * fq;
#pragma unroll
    for (int ai = 0; ai < 2; ++ai)
#pragma unroll
      for (int m = 0; m < 4; ++m) {
        bf16_t* rowp = YF + (size_t)(tok0 + u.pn * L + row0 + ai * HALF + m * 16) * 256 + col0;
#pragma unroll
        for (int bj = 0; bj < 2; ++bj) {
          const f32x4 v0 = acc[ai][bj][m][0] * scale, v1 = acc[ai][bj][m][1] * scale;
          *reinterpret_cast<uint4*>(rowp + bj * HALF) = make_uint4(pack2(v0[0], v0[1]), pack2(v0[2], v0[3]), pack2(v1[0], v1[1]), pack2(v1[2], v1[3]));
        }
      }
  }
};
struct EpiGate {
  static constexpr bool PERM = true;
  bf16_t* G; const float* bias;
  DEV void operator()(const f32x4 (&acc)[2][2][4][2], const Unit& u, int wr, int wc, int fr, int fq) const {
    const int row0 = u.pm * BM + wr * 64 + fr, col0 = u.pn * BM + wc * 32 + 8 * fq;
#pragma unroll
    for (int bj = 0; bj < 2; ++bj) {
      const float4 b0 = *reinterpret_cast<const float4*>(bias + col0 + bj * HALF);
      const float4 b1 = *reinterpret_cast<const float4*>(bias + col0 + bj * HALF + 4);
#pragma unroll
      for (int ai = 0; ai < 2; ++ai)
#pragma unroll
        for (int m = 0; m < 4; ++m) {
          const f32x4 v0 = acc[ai][bj][m][0], v1 = acc[ai][bj][m][1];
          float g0 = 1.f / (1.f + __expf(-(v0[0] + b0.x))), g1 = 1.f / (1.f + __expf(-(v0[1] + b0.y)));
          float g2 = 1.f / (1.f + __expf(-(v0[2] + b0.z))), g3 = 1.f / (1.f + __expf(-(v0[3] + b0.w)));
          float g4 = 1.f / (1.f + __expf(-(v1[0] + b1.x))), g5 = 1.f / (1.f + __expf(-(v1[1] + b1.y)));
          float g6 = 1.f / (1.f + __expf(-(v1[2] + b1.z))), g7 = 1.f / (1.f + __expf(-(v1[3] + b1.w)));
          *reinterpret_cast<uint4*>(G + (size_t)(row0 + ai * HALF + m * 16) * 1024 + col0 + bj * HALF) =
              make_uint4(pack2(g0, g1), pack2(g2, g3), pack2(g4, g5), pack2(g6, g7));
        }
    }
  }
};
struct EpiMerge {
  static constexpr bool PERM = true;
  const bf16_t* G; bf16_t* MERGED; int first;
  DEV void operator()(const f32x4 (&acc)[2][2][4][2], const Unit& u, int wr, int wc, int fr, int fq) const {
    const int row0 = u.pm * BM + wr * 64 + fr, col0 = u.pn * BM + wc * 32 + 8 * fq;
#pragma unroll
    for (int ai = 0; ai < 2; ++ai) {
      uint4 gv[4][2], pv[4][2];
#pragma unroll
      for (int m = 0; m < 4; ++m)
#pragma unroll
        for (int bj = 0; bj < 2; ++bj) {
          const size_t o = (size_t)(row0 + ai * HALF + m * 16) * 1024 + col0 + bj * HALF;
          gv[m][bj] = *reinterpret_cast<const uint4*>(G + o);
          pv[m][bj] = first ? make_uint4(0u, 0u, 0u, 0u) : *reinterpret_cast<const uint4*>(MERGED + o);
        }
#pragma unroll
      for (int m = 0; m < 4; ++m)
#pragma unroll
        for (int bj = 0; bj < 2; ++bj) {
          const size_t o = (size_t)(row0 + ai * HALF + m * 16) * 1024 + col0 + bj * HALF;
          const uint4 g4 = gv[m][bj], p4 = pv[m][bj];
          const f32x4 v0 = acc[ai][bj][m][0], v1 = acc[ai][bj][m][1];
          float r0 = bflo(g4.x) * v0[0] + bflo(p4.x), r1 = bfhi(g4.x) * v0[1] + bfhi(p4.x);
          float r2 = bflo(g4.y) * v0[2] + bflo(p4.y), r3 = bfhi(g4.y) * v0[3] + bfhi(p4.y);
          float r4 = bflo(g4.z) * v1[0] + bflo(p4.z), r5 = bfhi(g4.z) * v1[1] + bfhi(p4.z);
          float r6 = bflo(g4.w) * v1[2] + bflo(p4.w), r7 = bfhi(g4.w) * v1[3] + bfhi(p4.w);
          *reinterpret_cast<uint4*>(MERGED + o) = make_uint4(pack2(r0, r1), pack2(r2, r3), pack2(r4, r5), pack2(r6, r7));
        }
    }
  }
};
struct EpiResid {
  static constexpr bool PERM = true;
  float* out; float* Xc; const float* mod;
  const float* sx; const float* sc;
  DEV void operator()(const f32x4 (&acc)[2][2][4][2], const Unit& u, int wr, int wc, int fr, int fq) const {
    const int t0 = u.pm * BM;
    const int mr = t0 < NXTOK ? (t0 >> 12) : 8;
    float* xb = t0 < NXTOK ? out + (size_t)t0 * 1024 : Xc + (size_t)(t0 - NXTOK) * 1024;
    const float* xs = t0 < NXTOK ? sx + (size_t)t0 * 1024 : sc + (size_t)(t0 - NXTOK) * 1024;
    const float* gp = mod + (size_t)mr * 6144;
    const int rl0 = wr * 64 + fr, col0 = u.pn * BM + wc * 32 + 8 * fq;
#pragma unroll
    for (int bj = 0; bj < 2; ++bj)
#pragma unroll
      for (int n = 0; n < 2; ++n) {
        const int col = col0 + bj * HALF + n * 4;
        const float4 g = *reinterpret_cast<const float4*>(gp + col);
        float4 xin[2][4];
#pragma unroll
        for (int ai = 0; ai < 2; ++ai)
#pragma unroll
          for (int m = 0; m < 4; ++m)
            xin[ai][m] = *reinterpret_cast<const float4*>(xs + (size_t)(rl0 + ai * HALF + m * 16) * 1024 + col);
#pragma unroll
        for (int ai = 0; ai < 2; ++ai)
#pragma unroll
          for (int m = 0; m < 4; ++m) {
            const size_t xo = (size_t)(rl0 + ai * HALF + m * 16) * 1024 + col;
            float4 xv = xin[ai][m];
            const f32x4 a = acc[ai][bj][m][n];
            xv.x += g.x * a[0]; xv.y += g.y * a[1]; xv.z += g.z * a[2]; xv.w += g.w * a[3];
            *reinterpret_cast<float4*>(xb + xo) = xv;
          }
      }
  }
};
struct EpiAny {
  static constexpr bool PERM = true;
  int kind;
  const void *p0, *p1, *p2, *p3, *p4;
  int i0, i1; float f0;
  DEV void operator()(const f32x4 (&acc)[2][2][4][2], const Unit& u, int wr, int wc, int fr, int fq) const {
    asm volatile("" : "+v"(fr), "+v"(fq));
    switch (kind) {
      case 0: EpiStoreBf16{(bf16_t*)p0, i0}(acc, u, wr, wc, fr, fq); break;
      case 1: EpiFourier{(bf16_t*)p0, i0, i1, f0}(acc, u, wr, wc, fr, fq); break;
      case 2: EpiGate{(bf16_t*)p0, (const float*)p1}(acc, u, wr, wc, fr, fq); break;
      case 3: EpiMerge{(const bf16_t*)p0, (bf16_t*)p1, i0}(acc, u, wr, wc, fr, fq); break;
      default: EpiResid{(float*)p0, (float*)p1, (const float*)p2, (const float*)p3, (const float*)p4}(acc, u, wr, wc, fr, fq); break;
    }
  }
};
}

DEV void transpose_cvt(const float* __restrict__ src, int ldsrc, int K, int N, bf16_t* __restrict__ dst, int lddst,
                       int& base, char* smem) {
  float(*tile)[65] = reinterpret_cast<float(*)[65]>(smem);
  const int G = gdim();
  const int nkt = K >> 6, nnt = (N + 63) >> 6;
  const int ntile = nkt * nnt;
  int start = (bidx() - base) % G;
  if (start < 0) start += G;
  const int tid = tidx();
  for (int t = start; t < ntile; t += G) {
    const int kt = t % nkt, nt = t / nkt;
    const int k0 = kt << 6, n0 = nt << 6;
    {
      const int n = tid & 63;
      const bool okn = (n0 + n) < N;
#pragma unroll
      for (int p = 0; p < 8; ++p) {
        const int kk = (tid >> 6) + p * 8;
        tile[kk][n] = okn ? src[(size_t)(k0 + kk) * ldsrc + n0 + n] : 0.f;
      }
    }
    __syncthreads();
    {
      const int n = tid >> 3, kc = tid & 7;
      if (n0 + n < N) {
        unsigned w[4];
#pragma unroll
        for (int i = 0; i < 4; ++i) w[i] = pack2(tile[kc * 8 + 2 * i][n], tile[kc * 8 + 2 * i + 1][n]);
        *reinterpret_cast<uint4*>(dst + (size_t)(n0 + n) * lddst + k0 + kc * 8) = make_uint4(w[0], w[1], w[2], w[3]);
      }
    }
    __syncthreads();
  }
  base = (base + ntile) % G;
}

DEV void cvt_bf16(const float* __restrict__ src, bf16_t* __restrict__ dst, size_t n8) {
  const size_t gsz = (size_t)gdim() * NTHR;
  for (size_t i = (size_t)bidx() * NTHR + tidx(); i < n8; i += gsz) {
    float4 a = reinterpret_cast<const float4*>(src)[2 * i];
    float4 b = reinterpret_cast<const float4*>(src)[2 * i + 1];
    reinterpret_cast<uint4*>(dst)[i] = make_uint4(pack2(a.x, a.y), pack2(a.z, a.w), pack2(b.x, b.y), pack2(b.z, b.w));
  }
}

DEV void phase_prep(const Params& p, char* smem) {
  const int tid = tidx();
  const size_t gtid = (size_t)bidx() * NTHR + tid, gsz = (size_t)gdim() * NTHR;
  {
    const int lane = tid & 63;
    const int gw = bidx() * NWAVE + (tid >> 6), nw = gdim() * NWAVE;
    for (int r0 = gw * 4; r0 < 4 * 16384; r0 += nw * 4) {
      float4 v[4][4];
#pragma unroll
      for (int u = 0; u < 4; ++u) {
        const int r = r0 + u;
        const int tab = r >> 15, row = r & 32767;
        const float* src = (tab ? p.peer_up : p.peer_down) + (size_t)row * 1024 + lane * 16;
#pragma unroll
        for (int i = 0; i < 4; ++i) v[u][i] = reinterpret_cast<const float4*>(src)[i];
      }
#pragma unroll
      for (int u = 0; u < 4; ++u) {
        const int r = r0 + u;
        const int tab = r >> 15, row = r & 32767;
        float am = 0.f;
#pragma unroll
        for (int i = 0; i < 4; ++i)
          am = fmaxf(am, fmaxf(fmaxf(fabsf(v[u][i].x), fabsf(v[u][i].y)), fmaxf(fabsf(v[u][i].z), fabsf(v[u][i].w))));
        am = wave_max_f(am);
        const float inv = am > 0.f ? 5.9f / am : 0.f;
        const float scl = am > 0.f ? am / 5.9f : 0.f;
        unsigned w0 = 0u, w1 = 0u;
        w0 = __builtin_amdgcn_cvt_scalef32_pk_fp4_f32(w0, v[u][0].x * inv, v[u][0].y * inv, 1.0f, 0);
        w0 = __builtin_amdgcn_cvt_scalef32_pk_fp4_f32(w0, v[u][0].z * inv, v[u][0].w * inv, 1.0f, 1);
        w0 = __builtin_amdgcn_cvt_scalef32_pk_fp4_f32(w0, v[u][1].x * inv, v[u][1].y * inv, 1.0f, 2);
        w0 = __builtin_amdgcn_cvt_scalef32_pk_fp4_f32(w0, v[u][1].z * inv, v[u][1].w * inv, 1.0f, 3);
        w1 = __builtin_amdgcn_cvt_scalef32_pk_fp4_f32(w1, v[u][2].x * inv, v[u][2].y * inv, 1.0f, 0);
        w1 = __builtin_amdgcn_cvt_scalef32_pk_fp4_f32(w1, v[u][2].z * inv, v[u][2].w * inv, 1.0f, 1);
        w1 = __builtin_amdgcn_cvt_scalef32_pk_fp4_f32(w1, v[u][3].x * inv, v[u][3].y * inv, 1.0f, 2);
        w1 = __builtin_amdgcn_cvt_scalef32_pk_fp4_f32(w1, v[u][3].z * inv, v[u][3].w * inv, 1.0f, 3);
        unsigned char* dst = (tab ? p.PU8 : p.PD8) + (size_t)row * 512 + lane * 8;
        *reinterpret_cast<uint2*>(dst) = make_uint2(w0, w1);
        if (lane == 0) p.SD[row * 2 + tab] = scl;
      }
    }
  }
  cvt_bf16(p.peer_keys, p.KEYS, (size_t)2 * 16 * 128 * 16);
  for (size_t i = gtid; i < (size_t)4096 * 1024; i += gsz) {
    int k = (int)(i >> 10), j0 = (int)(i & 1023) * 8;
    int part = j0 >= 4096;
    int jj = j0 - (part ? 4096 : 0);
    float v[8];
#pragma unroll
    for (int e = 0; e < 8; ++e) {
      int ph = (k * (jj + e)) & 4095;
      v[e] = __builtin_amdgcn_cosf((float)ph * (1.0f / 4096.0f) - (part ? 0.25f : 0.f));
    }
    reinterpret_cast<uint4*>(p.A2)[i] = make_uint4(pack2(v[0], v[1]), pack2(v[2], v[3]), pack2(v[4], v[5]), pack2(v[6], v[7]));
  }
  for (size_t i = gtid; i < (size_t)256 * 64; i += gsz) {
    int k = (int)(i >> 6), j0 = (int)(i & 63) * 8;
    int part = j0 >= 256;
    int jj = j0 - (part ? 256 : 0);
    float v[8];
#pragma unroll
    for (int e = 0; e < 8; ++e) {
      int ph = (k * (jj + e)) & 255;
      float a = (float)ph * (1.0f / 128.0f);
      v[e] = part ? sinpif(a) : cospif(a);
    }
    reinterpret_cast<uint4*>(p.A2c)[i] = make_uint4(pack2(v[0], v[1]), pack2(v[2], v[3]), pack2(v[4], v[5]), pack2(v[6], v[7]));
  }
  for (size_t i = gtid; i < (size_t)512 * 32; i += gsz) {
    int r = (int)(i >> 5), c0 = (int)(i & 31) * 8;
    int m = r & 255, part = r >> 8;
    float v[8];
#pragma unroll
    for (int e = 0; e < 8; ++e) {
      int ph = (m * (c0 + e)) & 255;
      float a = (float)ph * (1.0f / 128.0f);
      v[e] = part ? -sinpif(a) : cospif(a);
    }
    reinterpret_cast<uint4*>(p.CS)[i] = make_uint4(pack2(v[0], v[1]), pack2(v[2], v[3]), pack2(v[4], v[5]), pack2(v[6], v[7]));
  }
  for (size_t i = gtid; i < 512; i += gsz) {
    const int pos = (int)(i >> 3), fi = (int)(i & 7);
    float ang = (float)pos * __expf(-(float)fi * 1.1512925465f);
    float sn, cs;
    sincosf(ang, &sn, &cs);
    p.ROPE[2 * i] = cs; p.ROPE[2 * i + 1] = sn;
  }
  for (size_t i = gtid; i < (size_t)2 * 256 * 1024; i += gsz) {
    int l = (int)(i >> 18), gc = (int)((i >> 10) & 255), d = (int)(i & 1023);
    int g = gc >> 6;
    const float* wg = p.w_grp + ((size_t)l * 256 + gc) * 64;
    const float* ps = p.pool_scale + l * 256 + g * 64;
    const float* wo = p.w_oc + ((size_t)l * 256 + g * 64) * 1024 + d;
    float s = 0.f;
    for (int j = 0; j < 64; ++j) s += wg[j] * ps[j] * wo[(size_t)j * 1024];
    p.WpcT[((size_t)l * 1024 + d) * 256 + gc] = f2bf(s);
  }
  for (size_t i = gtid; i < (size_t)2 * 96 * 128; i += gsz) {
    int l = (int)(i / (96 * 128));
    size_t r = i % (96 * 128);
    reinterpret_cast<uint4*>(p.WinT + ((size_t)l * 4096 + 928) * 1024)[r] = make_uint4(0, 0, 0, 0);
  }
  {
    float* sc = reinterpret_cast<float*>(smem);
    float* red = sc + 9 * 1024;
    bool loaded = false;
    for (int job = bidx(); job < 192; job += gdim()) {
      if (!loaded) {
        for (int i = tid; i < 9 * 1024; i += NTHR) {
          float v = (i < 8192) ? p.c[i] : p.c_ctx[i - 8192];
          sc[i] = v / (1.f + __expf(-v));
        }
        loaded = true;
      }
      __syncthreads();
      const int l = job / 96, c0 = (job % 96) * 64;
      {
        const int ks = tid >> 6, cl = tid & 63;
        const float* wp = p.w_mod + ((size_t)l * 1024 + ks * 128) * 6144 + c0 + cl;
        float a[9];
#pragma unroll
        for (int r = 0; r < 9; ++r) a[r] = 0.f;
#pragma unroll 2
        for (int k = 0; k < 128; k += 8) {
          float w[8];
#pragma unroll
          for (int e = 0; e < 8; ++e) w[e] = wp[(size_t)(k + e) * 6144];
#pragma unroll
          for (int r = 0; r < 9; ++r) {
            const float* sv = sc + r * 1024 + ks * 128 + k;
#pragma unroll
            for (int e = 0; e < 8; ++e) a[r] += sv[e] * w[e];
          }
        }
#pragma unroll
        for (int r = 0; r < 9; ++r) red[(ks * 9 + r) * 64 + cl] = a[r];
      }
      __syncthreads();
      for (int i = tid; i < 9 * 64; i += NTHR) {
        int r = i >> 6, cc = i & 63;
        float s = 0.f;
#pragma unroll
        for (int q = 0; q < 8; ++q) s += red[(q * 9 + r) * 64 + cc];
        p.MOD[((size_t)l * 9 + r) * 6144 + c0 + cc] = s + p.b_mod[l * 6144 + c0 + cc];
      }
      __syncthreads();
    }
    __syncthreads();
  }
  int base = 0;
  for (int l = 0; l < 2; ++l) {
    transpose_cvt(p.w_in + (size_t)l * 1024 * 4000, 4000, 1024, 928, p.WinT + (size_t)l * 4096 * 1024, 1024, base, smem);
    transpose_cvt(p.w_in + (size_t)l * 1024 * 4000 + 928, 4000, 1024, 3072, p.WinT + ((size_t)l * 4096 + 1024) * 1024,
                  1024, base, smem);
    transpose_cvt(p.w_uq + (size_t)l * 256 * 768, 768, 256, 768, p.WuqT + (size_t)l * 768 * 256, 256, base, smem);
    transpose_cvt(p.w_ukv + (size_t)l * 128 * 1024, 1024, 128, 1024, p.WukvT + (size_t)l * 1024 * 128, 128, base, smem);
    transpose_cvt(p.w_oa + (size_t)l * 512 * 1024, 1024, 512, 1024, p.WoaT + (size_t)l * 1024 * 512, 512, base, smem);
    transpose_cvt(p.w_ob + (size_t)l * 256 * 1024, 1024, 256, 1024, p.WobT + (size_t)l * 1024 * 256, 256, base, smem);
    transpose_cvt(p.w_out + (size_t)l * 1024 * 1024, 1024, 1024, 1024, p.WoutT + (size_t)l * 1024 * 1024, 1024, base, smem);
    transpose_cvt(p.w_pq + (size_t)l * 1024 * 2048, 2048, 1024, 2048, p.WpqT + (size_t)l * 2048 * 1024, 1024, base, smem);
  }
}

DEV void phase_ln(const Params& p, int l, const float* __restrict__ g, int shift_chunk, int ntok, bool from_input) {
  const int lane = tidx() & 63;
  const int gw = bidx() * NWAVE + (tidx() >> 6), nw = gdim() * NWAVE;
  for (int t = gw; t < ntok; t += nw) {
    const float* xr = from_input ? (t < NXTOK ? p.x + (size_t)t * 1024 : p.ctx + (size_t)(t - NXTOK) * 1024) : xrow(p, t);
    const int mr = t < NXTOK ? (t >> 12) : 8;
    const float* mod = p.MOD + ((size_t)l * 9 + mr) * 6144 + shift_chunk * 1024;
    float4 v[4];
    float ss = 0.f;
#pragma unroll
    for (int i = 0; i < 4; ++i) {
      v[i] = *reinterpret_cast<const float4*>(xr + i * 256 + lane * 4);
      ss += v[i].x * v[i].x + v[i].y * v[i].y + v[i].z * v[i].z + v[i].w * v[i].w;
    }
    ss = wave_sum(ss);
    const float rs = rsqrtf(ss * (1.f / 1024.f) + 1e-6f);
#pragma unroll
    for (int i = 0; i < 4; ++i) {
      const int cidx = i * 256 + lane * 4;
      float4 g4 = *reinterpret_cast<const float4*>(g + cidx);
      float4 sh = *reinterpret_cast<const float4*>(mod + cidx);
      float4 sc = *reinterpret_cast<const float4*>(mod + 1024 + cidx);
      float h0 = v[i].x * rs * g4.x * (1.f + sc.x) + sh.x;
      float h1 = v[i].y * rs * g4.y * (1.f + sc.y) + sh.y;
      float h2 = v[i].z * rs * g4.z * (1.f + sc.z) + sh.z;
      float h3 = v[i].w * rs * g4.w * (1.f + sc.w) + sh.w;
      *reinterpret_cast<uint2*>(p.H + (size_t)t * 1024 + cidx) = make_uint2(pack2(h0, h1), pack2(h2, h3));
    }
  }
}

DEV void phase_c1(const Params& p, int l) {
  const int lane = tidx() & 63;
  const int gw = bidx() * NWAVE + (tidx() >> 6), nw = gdim() * NWAVE;
  bf16_t* ZF = p.S1;
  bf16_t* Kb = p.R2 + (size_t)NTOK * 768;
  const int chunk = (NTOK + nw - 1) / nw;
  for (int ti = 0; ti < chunk; ++ti) {
    const int t = gw * chunk + ti;
    if (t >= NTOK) break;
    bf16_t* zr = ZF + (size_t)t * 1024;
    int b, lpos, L, tb, key;
    if (t < NXTOK) { b = t >> 12; lpos = t & 4095; L = 4096; tb = b * 4096; key = 256 + lpos; }
    else { int cidx = t - NXTOK; b = cidx >> 8; lpos = cidx & 255; L = 256; tb = NXTOK + b * 256; key = lpos; }
    const uint2 ucq = *reinterpret_cast<const uint2*>(zr + lane * 4);
    const unsigned uckv = *reinterpret_cast<const unsigned*>(zr + 256 + lane * 2);
    const int d = lane & 31;
    const bf16_t ukr = zr[384 + d];
    bf16_t pv[4][16], pself[4];
#pragma unroll
    for (int gi = 0; gi < 4; ++gi) {
      const int w = 2 << gi;
      const bf16_t* src = ZF + (size_t)tb * 1024 + 672 + gi * 64 + lane;
#pragma unroll
      for (int jj = 0; jj < w; ++jj) {
        int j = lpos - w / 2 + jj;
        int jc = j < 0 ? 0 : (j >= L ? L - 1 : j);
        pv[gi][jj] = src[(size_t)jc * 1024];
      }
      pself[gi] = src[(size_t)lpos * 1024];
    }
    const float4 gq = *reinterpret_cast<const float4*>(p.q_norm_g + l * 256 + lane * 4);
    const float2 gkv = *reinterpret_cast<const float2*>(p.kv_norm_g + l * 128 + lane * 2);
    {
      float a0 = bflo(ucq.x), a1 = bfhi(ucq.x), a2 = bflo(ucq.y), a3 = bfhi(ucq.y);
      float ss = wave_sum(a0 * a0 + a1 * a1 + a2 * a2 + a3 * a3);
      float rs = rsqrtf(ss * (1.f / 256.f) + 1e-6f);
      *reinterpret_cast<uint2*>(zr + lane * 4) = make_uint2(pack2(a0 * rs * gq.x, a1 * rs * gq.y), pack2(a2 * rs * gq.z, a3 * rs * gq.w));
    }
    {
      float a0 = bflo(uckv), a1 = bfhi(uckv);
      float ss = wave_sum(a0 * a0 + a1 * a1);
      float rs = rsqrtf(ss * (1.f / 128.f) + 1e-6f);
      *reinterpret_cast<unsigned*>(zr + 256 + lane * 2) = pack2(a0 * rs * gkv.x, a1 * rs * gkv.y);
    }
    {
      float val = bf2f(ukr);
      float partner = __shfl_xor(val, 8);
      float outv = val;
      if (t < NXTOK) {
        int i = d & 7;
        float pos = (float)((d < 16) ? (lpos >> 6) : (lpos & 63));
        const float2 csn = *reinterpret_cast<const float2*>(p.ROPE + ((int)pos * 8 + i) * 2);
        const float cs = csn.x, sn = csn.y;
        outv = (d & 8) ? (partner * sn + val * cs) : (val * cs - partner * sn);
      }
      if (lane < 32) {
        bf16_t ob = f2bf(outv);
#pragma unroll
        for (int h = 0; h < 8; ++h) Kb[((size_t)(b * 8 + h) * NKEY + key) * 96 + 64 + d] = ob;
      }
    }
#pragma unroll
    for (int gi = 0; gi < 4; ++gi) {
      const int w = 2 << gi;
      int lo = lpos - w / 2; if (lo < 0) lo = 0;
      int hi = lpos - w / 2 + w; if (hi > L) hi = L;
      float s2 = 0.f;
#pragma unroll
      for (int jj = 0; jj < w; ++jj) {
        int j = lpos - w / 2 + jj;
        s2 += (j >= 0 && j < L) ? bf2f(pv[gi][jj]) : 0.f;
      }
      p.POOLED[(size_t)t * 256 + gi * 64 + lane] = f2bf(s2 / (float)(hi - lo) - bf2f(pself[gi]));
    }
  }
}

DEV void phase_c2(const Params& p, int l, int ntt, char* smem) {
  const int lane = tidx() & 63, wave = tidx() >> 6;
  const int wm = wave >> 2, wn = wave & 3;
  const int quad = lane >> 4, l15 = lane & 15;
  const bf16_t* ZF = p.S1;
  bf16_t* Q = p.R2;
  bf16_t* Kb = p.R2 + (size_t)NTOK * 768;
  bf16_t* Vt = Kb + (size_t)64 * NKEY * 96;
  const int nq = ntt * 6, nkv = (NTOK / 128) * 8, nf = ntt * 4;
  const int total = nq + nkv + nf;
  for (int tile = xcd_remap(bidx(), gdim()); tile < total; tile += gdim()) {
    f32x4 acc[4][2];
    zero_acc(acc);
    if (tile < nq) {
      const int tt = tile / 6, tn = tile % 6;
      const int t0 = tt * 128, m0 = tn * 128;
      gemm_mainloop<2, 4>(p.WuqT + ((size_t)l * 768 + m0) * 256, 256, ZF + (size_t)t0 * 1024, 1024, 256, acc, smem);
      const float qs = 0.10206207261596577f * 1.4426950408889634f;
#pragma unroll
      for (int mi = 0; mi < 4; ++mi) {
        const int cb = m0 + wm * 64 + mi * 16;
        const int hc = cb % 96;
        const int ropek = hc < 64 ? 0 : (hc == 64 ? 1 : 2);
#pragma unroll
        for (int ni = 0; ni < 2; ++ni) {
          const int t = t0 + wn * 32 + ni * 16 + l15;
          float o[4];
#pragma unroll
          for (int j = 0; j < 4; ++j) {
            float v = acc[mi][ni][j];
            float partner = __shfl_xor(v, 32);
            float r = v;
            if (ropek != 0 && t < NXTOK) {
              int lpos = t & 4095;
              int i = (quad & 1) * 4 + j;
              float pos = (float)(ropek == 1 ? (lpos >> 6) : (lpos & 63));
              const float2 csn = *reinterpret_cast<const float2*>(p.ROPE + ((int)pos * 8 + i) * 2);
              const float cs = csn.x, sn = csn.y;
              r = (quad & 2) ? (partner * sn + v * cs) : (v * cs - partner * sn);
            }
            o[j] = r * qs;
          }
          *reinterpret_cast<uint2*>(Q + (size_t)t * 768 + cb + quad * 4) = make_uint2(pack2(o[0], o[1]), pack2(o[2], o[3]));
        }
      }
    } else if (tile < nq + nkv) {
      const int tl = tile - nq;
      const int tt = tl >> 3, h = tl & 7;
      const int t0 = tt * 128;
      gemm_mainloop<2, 4>(p.WukvT + ((size_t)l * 1024 + h * 128) * 128, 128, ZF + (size_t)t0 * 1024 + 256, 1024, 128, acc, smem);
#pragma unroll
      for (int mi = 0; mi < 4; ++mi)
#pragma unroll
        for (int ni = 0; ni < 2; ++ni) {
          const int t = t0 + wn * 32 + ni * 16 + l15;
          int b, key;
          if (t < NXTOK) { b = t >> 12; key = 256 + (t & 4095); }
          else { int ci = t - NXTOK; b = ci >> 8; key = ci & 255; }
          const int cc = mi * 16 + quad * 4;
          if (wm == 0) {
            *reinterpret_cast<uint2*>(Kb + ((size_t)(b * 8 + h) * NKEY + key) * 96 + cc) =
                make_uint2(pack2(acc[mi][ni][0], acc[mi][ni][1]), pack2(acc[mi][ni][2], acc[mi][ni][3]));
          } else {
#pragma unroll
            for (int j = 0; j < 4; ++j)
              Vt[((size_t)(b * 8 + h) * 64 + cc + j) * NKEY + key] = f2bf(acc[mi][ni][j]);
          }
        }
    } else {
      const int tl = tile - nq - nkv;
      const int tt = tl >> 2, tn = tl & 3;
      const int t0 = tt * 128, n0 = tn * 128;
      gemm_mainloop<2, 4>(ZF + (size_t)t0 * 1024 + 416, 1024, p.CS + (size_t)n0 * 256, 256, 256, acc, smem);
#pragma unroll
      for (int mi = 0; mi < 4; ++mi)
#pragma unroll
        for (int ni = 0; ni < 2; ++ni) {
          const int t = t0 + wm * 64 + mi * 16 + quad * 4;
          const int r = n0 + wn * 32 + ni * 16 + l15;
          const int m = r & 255, part = r >> 8;
          uint2 val = make_uint2(pack2(acc[mi][ni][0], acc[mi][ni][1]), pack2(acc[mi][ni][2], acc[mi][ni][3]));
          if (t < NXTOK) {
            int b = t >> 12, lp = t & 4095;
            *reinterpret_cast<uint2*>(p.UTx + ((size_t)(b * 256 + m)) * 8192 + part * 4096 + lp) = val;
          } else {
            int ci = t - NXTOK;
            int b = ci >> 8, lp = ci & 255;
            *reinterpret_cast<uint2*>(p.UTc + ((size_t)(b * 256 + m)) * 512 + part * 256 + lp) = val;
          }
        }
    }
  }
}

constexpr int ATT_BUF = 16384 + 64 * 136;

constexpr int ATT_KB = 16384, ATT_VB = 64 * 136, ATT_VOFF = 2 * ATT_KB;
DEV void attn_item(const Params& p, int b, int h, int q_t0, int nkt, char* smem) {
  const int tid = tidx(), lane = tid & 63, wave = tid >> 6;
  const int quad = lane >> 4, l15 = lane & 15;
  const bf16_t* Q = p.R2;
  const bf16_t* Kb = p.R2 + (size_t)NTOK * 768;
  const bf16_t* Vt = Kb + (size_t)64 * NKEY * 96;
  bf16_t* ATT = p.S1;
  bf16x8 qf[2][3];
#pragma unroll
  for (int qb = 0; qb < 2; ++qb) {
    const int t = q_t0 + wave * 32 + qb * 16 + l15;
#pragma unroll
    for (int s = 0; s < 3; ++s)
      qf[qb][s] = *reinterpret_cast<const bf16x8*>(Q + (size_t)t * 768 + h * 96 + s * 32 + quad * 8);
  }
  const bf16_t* kbase = Kb + (size_t)(b * 8 + h) * NKEY * 96;
  const bf16_t* vbase = Vt + (size_t)(b * 8 + h) * 64 * NKEY;
  f32x4 oacc[2][4];
  zero_acc(oacc);
  float m_run[2] = {-1e30f, -1e30f}, l_run[2] = {0.f, 0.f};
  const int kr0 = tid / 12, kc0 = tid % 12;
  const int kr1 = (tid + 512) / 12, kc1 = (tid + 512) % 12;
  const bool k2 = tid < 256;
  const int vd0 = tid >> 3, vkc = tid & 7;
  const bf16_t* gk0 = kbase + (size_t)kr0 * 96 + kc0 * 8;
  const bf16_t* gk1 = kbase + (size_t)kr1 * 96 + kc1 * 8;
  const bf16_t* gv = vbase + (size_t)vd0 * NKEY + vkc * 8;
  const int sk0 = kr0 * 256 + ((kc0 ^ (kr0 & 15)) << 4);
  const int sk1 = kr1 * 256 + ((kc1 ^ (kr1 & 15)) << 4);
  const int sv0 = ATT_VOFF + vd0 * 136 + vkc * 16;
  uint4 rk0, rk1 = make_uint4(0u, 0u, 0u, 0u), rv;
#define ATT_LDK(KT) { const size_t ko = (size_t)(KT) * 64 * 96; rk0 = *reinterpret_cast<const uint4*>(gk0 + ko); if (k2) rk1 = *reinterpret_cast<const uint4*>(gk1 + ko); }
#define ATT_LDV(KT) { rv = *reinterpret_cast<const uint4*>(gv + (size_t)(KT) * 64); }
#define ATT_STK(BUF) { char* sb_ = smem + (BUF) * ATT_KB; *reinterpret_cast<uint4*>(sb_ + sk0) = rk0; if (k2) *reinterpret_cast<uint4*>(sb_ + sk1) = rk1; }
#define ATT_STV(BUF) { char* sb_ = smem + (BUF) * ATT_VB; *reinterpret_cast<uint2*>(sb_ + sv0) = make_uint2(rv.x, rv.y); *reinterpret_cast<uint2*>(sb_ + sv0 + 8) = make_uint2(rv.z, rv.w); }
  auto qk = [&](int kbuf, f32x4 (&s)[2][4]) {
    const char* sk = smem + kbuf * ATT_KB;
    zero_acc(s);
    bf16x8 kf[4][3];
#pragma unroll
    for (int kb = 0; kb < 4; ++kb)
#pragma unroll
      for (int st = 0; st < 3; ++st) {
        const int row = kb * 16 + l15;
        const int chunk = st * 4 + quad;
        kf[kb][st] = *reinterpret_cast<const bf16x8*>(sk + row * 256 + ((chunk ^ l15) << 4));
      }
    __builtin_amdgcn_sched_barrier(0);
#pragma unroll
    for (int kb = 0; kb < 4; ++kb)
#pragma unroll
      for (int st = 0; st < 3; ++st)
#pragma unroll
        for (int qb = 0; qb < 2; ++qb) s[qb][kb] = __builtin_amdgcn_mfma_f32_16x16x32_bf16(kf[kb][st], qf[qb][st], s[qb][kb], 0, 0, 0);
  };
  auto softmax_pv = [&](int vbuf, f32x4 (&s)[2][4]) {
    const char* sv = smem + ATT_VOFF + vbuf * ATT_VB;
#pragma unroll
    for (int qb = 0; qb < 2; ++qb) {
      float mx = fmaxf(fmaxf(s[qb][0][0], s[qb][0][1]), fmaxf(s[qb][0][2], s[qb][0][3]));
#pragma unroll
      for (int kb = 1; kb < 4; ++kb)
        mx = fmaxf(mx, fmaxf(fmaxf(s[qb][kb][0], s[qb][kb][1]), fmaxf(s[qb][kb][2], s[qb][kb][3])));
      mx = xmax16(mx);
      mx = xmax32(mx);
      if (__builtin_amdgcn_ballot_w64(mx > m_run[qb] + 6.f) != 0ull) {
        const float mn = fmaxf(m_run[qb], mx);
        const float alpha = __builtin_amdgcn_exp2f(m_run[qb] - mn);
        m_run[qb] = mn;
        l_run[qb] *= alpha;
#pragma unroll
        for (int db = 0; db < 4; ++db) {
          oacc[qb][db][0] *= alpha; oacc[qb][db][1] *= alpha; oacc[qb][db][2] *= alpha; oacc[qb][db][3] *= alpha;
        }
      }
      const f32x2 mref2 = f32x2{m_run[qb], m_run[qb]};
      f32x2 ps2 = f32x2{0.f, 0.f};
#pragma unroll
      for (int kb = 0; kb < 4; ++kb)
#pragma unroll
        for (int jp = 0; jp < 2; ++jp) {
          f32x2 x = f32x2{s[qb][kb][2 * jp], s[qb][kb][2 * jp + 1]} - mref2;
          f32x2 e = f32x2{__builtin_amdgcn_exp2f(x[0]), __builtin_amdgcn_exp2f(x[1])};
          s[qb][kb][2 * jp] = e[0];
          s[qb][kb][2 * jp + 1] = e[1];
          ps2 += e;
        }
      l_run[qb] += ps2[0] + ps2[1];
    }
    bf16x8 vf[2][4];
#pragma unroll
    for (int ks = 0; ks < 2; ++ks)
#pragma unroll
      for (int db = 0; db < 4; ++db) {
        const int d = db * 16 + l15;
        uint2 lo = *reinterpret_cast<const uint2*>(sv + d * 136 + (ks * 32 + quad * 4) * 2);
        uint2 hi = *reinterpret_cast<const uint2*>(sv + d * 136 + (ks * 32 + 16 + quad * 4) * 2);
        vf[ks][db] = mk8(lo, hi);
      }
    __builtin_amdgcn_sched_barrier(0);
#pragma unroll
    for (int ks = 0; ks < 2; ++ks) {
      bf16x8 pf[2];
#pragma unroll
      for (int qb = 0; qb < 2; ++qb) pf[qb] = pack8(s[qb][2 * ks], s[qb][2 * ks + 1]);
#pragma unroll
      for (int db = 0; db < 4; ++db)
#pragma unroll
        for (int qb = 0; qb < 2; ++qb) oacc[qb][db] = __builtin_amdgcn_mfma_f32_16x16x32_bf16(vf[ks][db], pf[qb], oacc[qb][db], 0, 0, 0);
    }
  };
  f32x4 sA[2][4], sB[2][4];
  ATT_LDK(0) ATT_LDV(0)
  ATT_STK(0) ATT_STV(0)
  if (nkt > 1) { ATT_LDK(1) ATT_STK(1) }
  __syncthreads();
  qk(0, sA);
  if (nkt > 2) ATT_LDK(2)
  if (nkt > 1) ATT_LDV(1)
  __syncthreads();
  for (int t = 0; t < nkt; t += 2) {
    if (t + 1 < nkt) qk(1, sB);
    softmax_pv(0, sA);
    if (t + 2 < nkt) ATT_STK(0)
    if (t + 1 < nkt) ATT_STV(1)
    if (t + 3 < nkt) ATT_LDK(t + 3)
    if (t + 2 < nkt) ATT_LDV(t + 2)
    __syncthreads();
    if (t + 1 >= nkt) break;
    if (t + 2 < nkt) qk(0, sA);
    softmax_pv(1, sB);
    if (t + 3 < nkt) ATT_STK(1)
    if (t + 2 < nkt) ATT_STV(0)
    if (t + 4 < nkt) ATT_LDK(t + 4)
    if (t + 3 < nkt) ATT_LDV(t + 3)
    __syncthreads();
  }
#undef ATT_LDK
#undef ATT_LDV
#undef ATT_STK
#undef ATT_STV
#pragma unroll
  for (int qb = 0; qb < 2; ++qb) {
    float lt = l_run[qb];
    lt = xsum16(lt);
    lt = xsum32(lt);
    const float inv = 1.f / lt;
    const int t = q_t0 + wave * 32 + qb * 16 + l15;
#pragma unroll
    for (int db = 0; db < 4; ++db)
      *reinterpret_cast<uint2*>(ATT + (size_t)t * 512 + h * 64 + db * 16 + quad * 4) =
          make_uint2(pack2(oacc[qb][db][0] * inv, oacc[qb][db][1] * inv), pack2(oacc[qb][db][2] * inv, oacc[qb][db][3] * inv));
  }
}

DEV void phase_attn(const Params& p, int l, char* smem) {
  const int c = bidx();
  const int x = c & 7, j = c >> 3;
  int first, cnt;
  if (j < 16) { first = j * 3; cnt = 3; } else { first = 48 + (j - 16) * 5; cnt = 5; }
  for (int i = 0; i < cnt; ++i) {
    const int it = x * 128 + first + i;
    const int b = it >> 7, h = (it >> 4) & 7, qb = it & 15;
    attn_item(p, b, h, b * 4096 + qb * 256, NKEY / 64, smem);
  }
  if (l == 0 && j < 8) {
    const int it = x * 8 + j;
    const int b = it >> 3, h = it & 7;
    attn_item(p, b, h, NXTOK + b * 256, 4, smem);
  }
}

DEV void phase_i(const Params& p, int l, int ntok, char* smem) {
  const int tid = tidx(), lane = tid & 63, wave = tid >> 6;
  const int quad = lane >> 4, l15 = lane & 15;
  const bf16_t* PQ = p.S1;
  float* SV = sv_ptr(p);
  unsigned char* SI = si_ptr(p);
  const int chunk = ntok / 16;
  const int ngrp = chunk / 16;
  for (int task = bidx(); task < 256; task += gdim()) {
    const int hp = task >> 4, ck = task & 15;
    __syncthreads();
    {
      const bf16_t* kp = p.KEYS + ((size_t)l * 16 + hp) * 128 * 128;
#pragma unroll
      for (int q = 0; q < 4; ++q) {
        const int id = tid + q * 512;
        const int r = id >> 4, c = id & 15;
        uint4 v = *reinterpret_cast<const uint4*>(kp + (size_t)r * 128 + c * 8);
        *reinterpret_cast<uint4*>(smem + r * 256 + ((c ^ (r & 15)) << 4)) = v;
      }
    }
    __syncthreads();
    bf16x8 qn[4];
    if (wave < ngrp) {
      const int t1 = ck * chunk + wave * 16 + l15;
#pragma unroll
      for (int s2 = 0; s2 < 4; ++s2)
        qn[s2] = *reinterpret_cast<const bf16x8*>(PQ + (size_t)t1 * 2048 + hp * 128 + s2 * 32 + quad * 8);
    }
    for (int gi = wave; gi < ngrp; gi += NWAVE) {
      const int t = ck * chunk + gi * 16 + l15;
      bf16x8 qf[4];
#pragma unroll
      for (int s2 = 0; s2 < 4; ++s2) qf[s2] = qn[s2];
      if (gi + NWAVE < ngrp) {
        const int t2 = t + NWAVE * 16;
#pragma unroll
        for (int s2 = 0; s2 < 4; ++s2)
          qn[s2] = *reinterpret_cast<const bf16x8*>(PQ + (size_t)t2 * 2048 + hp * 128 + s2 * 32 + quad * 8);
      }
      f32x4 sc[8];
#pragma unroll
      for (int kb = 0; kb < 8; ++kb) {
        sc[kb] = f32x4{0.f, 0.f, 0.f, 0.f};
#pragma unroll
        for (int s2 = 0; s2 < 4; ++s2) {
          const int row = kb * 16 + l15, c = s2 * 4 + quad;
          bf16x8 a = *reinterpret_cast<const bf16x8*>(smem + row * 256 + ((c ^ l15) << 4));
          sc[kb] = __builtin_amdgcn_mfma_f32_16x16x32_bf16(a, qf[s2], sc[kb], 0, 0, 0);
        }
      }
      unsigned key[32];
#pragma unroll
      for (int kb = 0; kb < 8; ++kb)
#pragma unroll
        for (int j = 0; j < 4; ++j) {
          unsigned u = orderable(sc[kb][j]);
          int kidx = kb * 16 + quad * 4 + j;
          key[kb * 4 + j] = (u & ~127u) | (unsigned)(127 - kidx);
        }
#pragma unroll
      for (int k = 2; k <= 32; k <<= 1)
#pragma unroll
        for (int j = k >> 1; j > 0; j >>= 1)
#pragma unroll
          for (int i = 0; i < 32; ++i) {
            const int pr = i ^ j;
            if (pr > i) {
              const unsigned a = key[i], b2 = key[pr];
              const unsigned hi = a > b2 ? a : b2, lo = a > b2 ? b2 : a;
              const bool desc = ((i & k) == 0);
              key[i] = desc ? hi : lo;
              key[pr] = desc ? lo : hi;
            }
          }
      float* svp = SV + ((size_t)t * 16 + hp) * 16;
      unsigned out4[4] = {0u, 0u, 0u, 0u};
#pragma unroll
      for (int r = 0; r < 16; ++r) {
        unsigned m = key[0];
        m = xmaxu16(m);
        m = xmaxu32(m);
        const bool take = (key[0] == m);
#pragma unroll
        for (int i = 0; i < 15 - r; ++i) key[i] = take ? key[i + 1] : key[i];
        key[15 - r] = take ? 0u : key[15 - r];
        out4[r & 3] = (quad == (r >> 2)) ? m : out4[r & 3];
      }
      *reinterpret_cast<uint4*>(reinterpret_cast<unsigned*>(svp) + 4 * quad) = make_uint4(out4[0], out4[1], out4[2], out4[3]);
    }
  }
}

DEV float gelu_tanh(float a) {
  float u = 0.7978845608028654f * (a + 0.044715f * a * a * a);
  float e = __expf(2.f * u);
  float th = 1.f - 2.f / (e + 1.f);
  return 0.5f * a * (1.f + th);
}

template <bool DRY>
DEV void phase_j(const Params& p, int l, int ntok, bool last, char* smem) {
  const int lane = tidx() & 63, wave = tidx() >> 6;
  const int gw = bidx() * NWAVE + wave, nw = gdim() * NWAVE;
  const float* SV = sv_ptr(p);
  const unsigned char* SI = si_ptr(p);
  int* eidx_s = reinterpret_cast<int*>(smem) + wave * 128;
  float* gate_s = reinterpret_cast<float*>(smem + 4096) + wave * 128;
  float* sd_s = reinterpret_cast<float*>(smem + 8192) + wave * 128;
  int ca = -1, cb = 0;
  {
    int cnt = 0;
#pragma unroll
    for (int a = 0; a < 16; ++a) {
      int nb = 16 / (a + 1);
      if (lane >= cnt && lane < cnt + nb) { ca = a; cb = lane - cnt; }
      cnt += nb;
    }
  }
  const bool valid = ca >= 0;
  const int ca_ = valid ? ca : 0;
  for (int t = gw; t < ntok; t += nw) {
    {
      float s0v[8], s1v[8];
      int i0v[8], i1v[8];
      unsigned* svl = reinterpret_cast<unsigned*>(smem + 16384) + wave * 256;
      {
        const uint4 blk = *reinterpret_cast<const uint4*>(reinterpret_cast<const unsigned*>(SV) + (size_t)t * 256 + lane * 4);
        *reinterpret_cast<uint4*>(svl + lane * 4) = blk;
        asm volatile("s_waitcnt lgkmcnt(0)" ::: "memory");
      }
#pragma unroll
      for (int h = 0; h < 8; ++h) {
        const unsigned m0 = svl[(h * 2) * 16 + ca_], m1 = svl[(h * 2 + 1) * 16 + cb];
        s0v[h] = unorderable((m0 & ~127u) | 64u); s1v[h] = unorderable((m1 & ~127u) | 64u);
        i0v[h] = 127 - (int)(m0 & 127u); i1v[h] = 127 - (int)(m1 & 127u);
      }
#pragma unroll
      for (int h = 0; h < 8; ++h) {
        const float scv = s0v[h] + s1v[h];
        const unsigned key = valid ? ((orderable(scv) & ~63u) | (unsigned)(63 - lane)) : 0u;
        int rank = 0;
#pragma unroll
        for (int i = 0; i < 50; ++i) {
          const unsigned ki = (unsigned)__builtin_amdgcn_readlane((int)key, i);
          rank += (ki > key) ? 1 : 0;
        }
        const bool sel = valid && rank < 16;
        const float smax = __builtin_bit_cast(float, __builtin_amdgcn_readlane(__builtin_bit_cast(int, scv), 0));
        const float e = sel ? __expf(scv - smax) : 0.f;
        const float es = wave_sum(e);
        if (sel) {
          const int ex = i0v[h] * 128 + i1v[h];
          eidx_s[h * 16 + rank] = ex;
          const float2 sc2 = *reinterpret_cast<const float2*>(p.SD + (size_t)(l * 16384 + ex) * 2);
          gate_s[h * 16 + rank] = (e / es) * sc2.y;
          sd_s[h * 16 + rank] = sc2.x;
        }
      }
    }
    asm volatile("s_waitcnt lgkmcnt(0)" ::: "memory");
    const bf16_t* hrow = p.H + (size_t)t * 1024 + lane * 16;
    f32x2 hf2[8];
    {
      uint4 hv0 = *reinterpret_cast<const uint4*>(hrow);
      uint4 hv1 = *reinterpret_cast<const uint4*>(hrow + 8);
      unsigned hw[8] = {hv0.x, hv0.y, hv0.z, hv0.w, hv1.x, hv1.y, hv1.z, hv1.w};
#pragma unroll
      for (int q = 0; q < 8; ++q) hf2[q] = f32x2{bflo(hw[q]), bfhi(hw[q])};
    }
    f32x2 acc2[8];
#pragma unroll
    for (int i = 0; i < 8; ++i) acc2[i] = f32x2{0.f, 0.f};
    const auto rsD = __builtin_amdgcn_make_buffer_rsrc((void*)(p.PD8 + (size_t)l * 16384 * 512), 0, 16384 * 512, 0x00020000);
    const auto rsU = __builtin_amdgcn_make_buffer_rsrc((void*)(p.PU8 + (size_t)l * 16384 * 512), 0, 16384 * 512, 0x00020000);
    uint2 dA[8], uA[8], dB[8], uB[8];
#define PEER_LOAD(D, U, KB)                                                                \
  _Pragma("unroll") for (int i = 0; i < 8; ++i) {                                          \
    const int e = __builtin_amdgcn_readfirstlane(eidx_s[(KB) * 8 + i]);     \
    D[i] = __builtin_bit_cast(uint2, __builtin_amdgcn_raw_buffer_load_b64(rsD, lane * 8, e * 512, 0)); \
    U[i] = __builtin_bit_cast(uint2, __builtin_amdgcn_raw_buffer_load_b64(rsU, lane * 8, e * 512, 0)); \
  }
#define PEER_COMP(D, U, KB)                                                                \
  {                                                                                        \
    float dots[8];                                                                         \
    _Pragma("unroll") for (int i = 0; i < 8; ++i) {                                        \
      unsigned dw[2] = {D[i].x, D[i].y};                                                   \
      f32x2 d2 = f32x2{0.f, 0.f};                                                          \
      _Pragma("unroll") for (int q = 0; q < 2; ++q) {                                      \
        d2 = hf2[4 * q + 0] * __builtin_amdgcn_cvt_scalef32_pk_f32_fp4(dw[q], 1.0f, 0) + d2; \
        d2 = hf2[4 * q + 1] * __builtin_amdgcn_cvt_scalef32_pk_f32_fp4(dw[q], 1.0f, 1) + d2; \
        d2 = hf2[4 * q + 2] * __builtin_amdgcn_cvt_scalef32_pk_f32_fp4(dw[q], 1.0f, 2) + d2; \
        d2 = hf2[4 * q + 3] * __builtin_amdgcn_cvt_scalef32_pk_f32_fp4(dw[q], 1.0f, 3) + d2; \
      }                                                                                    \
      dots[i] = wave_sum(d2[0] + d2[1]);                                                   \
    }                                                                                      \
    float mine = dots[0];                                                                  \
    _Pragma("unroll") for (int i = 1; i < 8; ++i) mine = ((lane & 7) == i) ? dots[i] : mine; \
    const float av = gate_s[(KB) * 8 + (lane & 7)] * gelu_tanh(mine * sd_s[(KB) * 8 + (lane & 7)]); \
    _Pragma("unroll") for (int i = 0; i < 8; ++i) {                                        \
      const float act = __builtin_bit_cast(float, __builtin_amdgcn_readlane(__builtin_bit_cast(int, av), i)); \
      const f32x2 act2 = f32x2{act, act};                                                  \
      unsigned uw[2] = {U[i].x, U[i].y};                                                   \
      _Pragma("unroll") for (int q = 0; q < 2; ++q) {                                      \
        acc2[4 * q + 0] = act2 * __builtin_amdgcn_cvt_scalef32_pk_f32_fp4(uw[q], 1.0f, 0) + acc2[4 * q + 0]; \
        acc2[4 * q + 1] = act2 * __builtin_amdgcn_cvt_scalef32_pk_f32_fp4(uw[q], 1.0f, 1) + acc2[4 * q + 1]; \
        acc2[4 * q + 2] = act2 * __builtin_amdgcn_cvt_scalef32_pk_f32_fp4(uw[q], 1.0f, 2) + acc2[4 * q + 2]; \
        acc2[4 * q + 3] = act2 * __builtin_amdgcn_cvt_scalef32_pk_f32_fp4(uw[q], 1.0f, 3) + acc2[4 * q + 3]; \
      }                                                                                    \
    }                                                                                      \
  }
    PEER_LOAD(dA, uA, 0)
#pragma unroll 1
    for (int kb = 0; kb < 16; kb += 2) {
      PEER_LOAD(dB, uB, kb + 1)
      PEER_COMP(dA, uA, kb)
      if (kb + 2 < 16) { PEER_LOAD(dA, uA, kb + 2) }
      PEER_COMP(dB, uB, kb + 1)
    }
#undef PEER_LOAD
#undef PEER_COMP
    int lane_r = lane, t_r = t;
    asm volatile("" : "+v"(lane_r), "+v"(t_r));
    const int mr = t_r < NXTOK ? (t_r >> 12) : 8;
    const float* g2 = p.MOD + ((size_t)l * 9 + mr) * 6144 + 5 * 1024 + lane_r * 16;
    float* xr = xrow(p, t_r) + lane_r * 16;
    float xn[16];
    float ss = 0.f;
#pragma unroll
    for (int q4 = 0; q4 < 4; ++q4) {
      float4 xv = *reinterpret_cast<const float4*>(xr + q4 * 4);
      float4 gv = *reinterpret_cast<const float4*>(g2 + q4 * 4);
      const int a0 = q4 * 4;
      xn[a0 + 0] = xv.x + gv.x * acc2[2 * q4][0];
      xn[a0 + 1] = xv.y + gv.y * acc2[2 * q4][1];
      xn[a0 + 2] = xv.z + gv.z * acc2[2 * q4 + 1][0];
      xn[a0 + 3] = xv.w + gv.w * acc2[2 * q4 + 1][1];
      ss += xn[a0] * xn[a0] + xn[a0 + 1] * xn[a0 + 1] + xn[a0 + 2] * xn[a0 + 2] + xn[a0 + 3] * xn[a0 + 3];
    }
    float rs = 1.f;
    if (last) {
      ss = wave_sum(ss);
      rs = rsqrtf(ss * (1.f / 1024.f) + 1e-6f);
    }
#pragma unroll
    for (int q4 = 0; q4 < 4; ++q4) {
      const int a0 = q4 * 4;
      float4 o = make_float4(xn[a0], xn[a0 + 1], xn[a0 + 2], xn[a0 + 3]);
      if (last) {
        float4 fg = *reinterpret_cast<const float4*>(p.final_g + lane_r * 16 + q4 * 4);
        o.x *= rs * fg.x; o.y *= rs * fg.y; o.z *= rs * fg.z; o.w *= rs * fg.w;
      }
      if (!DRY || o.x == 1.2345e33f) *reinterpret_cast<float4*>(xr + q4 * 4) = o;
    }
    if (!last) {
      const float rs1 = rsqrtf(wave_sum(ss) * (1.f / 1024.f) + 1e-6f);
      const float* g1 = p.norm1_g + (l + 1) * 1024 + lane_r * 16;
      const float* md = p.MOD + ((size_t)(l + 1) * 9 + mr) * 6144 + lane_r * 16;
      unsigned hw2[8];
#pragma unroll
      for (int q4 = 0; q4 < 4; ++q4) {
        const float4 gg = *reinterpret_cast<const float4*>(g1 + q4 * 4);
        const float4 sh = *reinterpret_cast<const float4*>(md + q4 * 4);
        const float4 sc = *reinterpret_cast<const float4*>(md + 1024 + q4 * 4);
        const int a0 = q4 * 4;
        const float h0 = xn[a0] * rs1 * gg.x * (1.f + sc.x) + sh.x;
        const float h1 = xn[a0 + 1] * rs1 * gg.y * (1.f + sc.y) + sh.y;
        const float h2 = xn[a0 + 2] * rs1 * gg.z * (1.f + sc.z) + sh.z;
        const float h3 = xn[a0 + 3] * rs1 * gg.w * (1.f + sc.w) + sh.w;
        hw2[2 * q4] = pack2(h0, h1); hw2[2 * q4 + 1] = pack2(h2, h3);
      }
      bf16_t* hdst = p.H + (size_t)t_r * 1024 + lane_r * 16;
      *reinterpret_cast<uint4*>(hdst) = make_uint4(hw2[0], hw2[1], hw2[2], hw2[3]);
      *reinterpret_cast<uint4*>(hdst + 8) = make_uint4(hw2[4], hw2[5], hw2[6], hw2[7]);
    }
    asm volatile("s_waitcnt lgkmcnt(0)" ::: "memory");
  }
}

__global__ void __launch_bounds__(512, 2) mega_kernel(Params p) {
  __shared__ __attribute__((aligned(16))) char smem[SMEM_BYTES + 16];
  cg::grid_group grid = cg::this_grid();
  if (threadIdx.x == 0) *reinterpret_cast<uint4*>(smem + SMEM_BYTES) = make_uint4(0u, 0u, 0u, 0u);
  __syncthreads();
  XcdBarrier xb = xcd_barrier_post(p.BAR, reinterpret_cast<volatile unsigned*>(smem + SMEM_BYTES));
  phase_prep(p, smem);
  xcd_barrier(xb);
#pragma unroll 1
  for (int l = 0; l < 2; ++l) {
    const bool last = (l == 1);
    const int ntok = last ? NXTOK : NTOK;
    const int ntt = ntok / 128;
#pragma unroll 1
    for (int st = 0; st < 18; ++st) {
      bool is_gemm = false, bar = true;
      g8::Gemm g{nullptr, nullptr, 0, 0, 0};
      g8::Order S{1, 0, gdim(), -1};
      g8::EpiAny E{0, nullptr, nullptr, nullptr, nullptr, nullptr, 0, 0, 0.f};
      const int G = gdim(), cb = bidx();
      const int cr = xcd_remap(cb, G);
      bf16_t* YF = p.S1 + (size_t)NTOK * 512;
      bf16_t* MERGED = p.R2;
      bf16_t* TMPG = p.R2 + (size_t)NTOK * 1024;
      switch (st) {
        case 0: if (l == 0) phase_ln(p, l, p.norm1_g + l * 1024, 0, NTOK, true); else bar = false; break;
        case 1:
          g = g8::Gemm{p.H, p.WinT + (size_t)l * 4096 * 1024, 1024, 1024, 1024};
          S = g8::Order{4, (NTOK / 256) * 4, G, cr};
          E.kind = 0; E.p0 = p.S1; E.i0 = 1024; is_gemm = true; break;
        case 2: phase_c1(p, l); break;
        case 3: phase_c2(p, l, ntt, smem); break;
        case 4:
          g = g8::Gemm{p.A2, p.UTx, 8192, 8192, 8192};
          S = g8::Order{8, 128, G, (cb >> 3) < 16 ? (cb & 7) * 16 + (cb >> 3) : -1};
          E.kind = 1; E.p0 = YF; E.i0 = 0; E.i1 = 4096; E.f0 = 1.f / 1024.f; is_gemm = true; bar = false; break;
        case 5:
          if (l == 0) {
            g = g8::Gemm{p.A2c, p.UTc, 512, 512, 512};
            S = g8::Order{8, 8, G, (cb >> 3) == 8 ? (cb & 7) : -1};
            E.kind = 1; E.p0 = YF; E.i0 = NXTOK; E.i1 = 256; E.f0 = 1.f / 256.f; is_gemm = true;
          }
          bar = false; break;
        case 6: phase_attn(p, l, smem); break;
        case 7: case 9: case 11: {
          const int br = (st - 7) >> 1;
          g = g8::Gemm{p.H, p.WinT + ((size_t)l * 4096 + 1024 + br * 1024) * 1024, 1024, 1024, 1024};
          S = g8::Order{4, (ntok / 256) * 4, G, cr};
          E.kind = 2; E.p0 = TMPG; E.p1 = p.b_gate + (size_t)l * 3072 + br * 1024; is_gemm = true; bar = false; break;
        }
        case 8: case 10: case 12: {
          const int br = (st - 8) >> 1;
          const bf16_t* Ab; const bf16_t* Wb; int Kb_;
          if (br == 0) { Ab = p.S1; Wb = p.WoaT + (size_t)l * 1024 * 512; Kb_ = 512; }
          else if (br == 1) { Ab = YF; Wb = p.WobT + (size_t)l * 1024 * 256; Kb_ = 256; }
          else { Ab = p.POOLED; Wb = p.WpcT + (size_t)l * 1024 * 256; Kb_ = 256; }
          g = g8::Gemm{Ab, Wb, Kb_, Kb_, Kb_};
          S = g8::Order{4, (ntok / 256) * 4, G, cr};
          E.kind = 3; E.p0 = TMPG; E.p1 = MERGED; E.i0 = (br == 0) ? 1 : 0; is_gemm = true; bar = (st == 12); break;
        }
        case 13:
          g = g8::Gemm{MERGED, p.WoutT + (size_t)l * 1024 * 1024, 1024, 1024, 1024};
          S = g8::Order{4, (ntok / 256) * 4, G, cr};
          E.kind = 4; E.p0 = p.out; E.p1 = p.Xc; E.p2 = p.MOD + (size_t)l * 9 * 6144 + 2 * 1024;
          E.p3 = (l == 0) ? p.x : p.out; E.p4 = (l == 0) ? p.ctx : p.Xc; is_gemm = true; break;
        case 14: phase_ln(p, l, p.norm2_g + l * 1024, 3, ntok, false); break;
        case 15:
          g = g8::Gemm{p.H, p.WpqT + (size_t)l * 2048 * 1024, 1024, 1024, 1024};
          S = g8::Order{8, (ntok / 256) * 8, G, cr};
          E.kind = 0; E.p0 = p.S1; E.i0 = 2048; is_gemm = true; break;
        case 16: phase_i(p, l, ntok, smem); break;
        default: phase_j<false>(p, l, ntok, last, smem); bar = !last; break;
      }
      if (is_gemm) g8::gemm_phase((LAS unsigned char*)(smem), g, S, E);
      if (bar) xcd_barrier(xb);
    }
  }
  grid.sync();
}

extern "C" void kernel_launch(void* const* d_in, const int* in_sizes, int n_in, void* d_out, int out_size, void* d_ws,
                              size_t ws_size, hipStream_t stream) {
  Params p{};
  const float** fp = reinterpret_cast<const float**>(&p);
  for (int i = 0; i < 25; ++i) fp[i] = reinterpret_cast<const float*>(d_in[i]);
  p.out = reinterpret_cast<float*>(d_out);
  char* w = reinterpret_cast<char*>(d_ws);
  size_t off = 0;
  auto take = [&](size_t bytes) { char* r = w + off; off += (bytes + 255) & ~(size_t)255; return r; };
  p.Xc = (float*)take((size_t)2048 * 1024 * 4);
  p.H = (bf16_t*)take((size_t)NTOK * 1024 * 2);
  p.S1 = (bf16_t*)take((size_t)NTOK * 1024 * 2);
  p.UTx = (bf16_t*)take((size_t)8 * 256 * 8192 * 2);
  p.UTc = (bf16_t*)take((size_t)8 * 256 * 512 * 2);
  p.POOLED = (bf16_t*)take((size_t)NTOK * 256 * 2);
  p.R2 = (bf16_t*)take((size_t)NTOK * 768 * 2 + (size_t)64 * NKEY * 96 * 2 + (size_t)64 * 64 * NKEY * 2);
  p.WinT = (bf16_t*)take((size_t)2 * 4096 * 1024 * 2);
  p.WuqT = (bf16_t*)take((size_t)2 * 768 * 256 * 2);
  p.WukvT = (bf16_t*)take((size_t)2 * 1024 * 128 * 2);
  p.WoaT = (bf16_t*)take((size_t)2 * 1024 * 512 * 2);
  p.WobT = (bf16_t*)take((size_t)2 * 1024 * 256 * 2);
  p.WpcT = (bf16_t*)take((size_t)2 * 1024 * 256 * 2);
  p.WoutT = (bf16_t*)take((size_t)2 * 1024 * 1024 * 2);
  p.WpqT = (bf16_t*)take((size_t)2 * 2048 * 1024 * 2);
  p.KEYS = (bf16_t*)take((size_t)2 * 16 * 128 * 128 * 2);
  p.PD8 = (unsigned char*)take((size_t)2 * 16384 * 1024);
  p.PU8 = (unsigned char*)take((size_t)2 * 16384 * 1024);
  p.SD = (float*)take((size_t)2 * 16384 * 4);
  p.SU = (float*)take((size_t)2 * 16384 * 4);
  p.BAR = (unsigned*)take((size_t)XCD_BAR_WORDS * 4);
  p.ROPE = (float*)take((size_t)64 * 8 * 2 * 4);
  p.A2 = (bf16_t*)take((size_t)4096 * 8192 * 2);
  p.A2c = (bf16_t*)take((size_t)256 * 512 * 2);
  p.CS = (bf16_t*)take((size_t)512 * 256 * 2);
  p.MOD = (float*)take((size_t)2 * 9 * 6144 * 4);
  if (off > ws_size) fprintf(stderr, "workspace too small: need %zu have %zu\n", off, ws_size);

  static int grid_blocks = 0;
  if (!grid_blocks) {
    int dev = 0, cus = 0, per_cu = 0;
    (void)hipGetDevice(&dev);
    (void)hipDeviceGetAttribute(&cus, hipDeviceAttributeMultiprocessorCount, dev);
    (void)hipOccupancyMaxActiveBlocksPerMultiprocessor(&per_cu, mega_kernel, NTHR, 0);
    if (per_cu > 1) per_cu = 1;
    if (per_cu < 1) per_cu = 1;
    grid_blocks = cus * per_cu;
  }
  (void)hipMemsetAsync(p.BAR, 0, (size_t)XCD_BAR_WORDS * 4, stream);
  void* args[] = {&p};
  hipError_t e = hipLaunchCooperativeKernel((void*)mega_kernel, dim3(grid_blocks), dim3(NTHR), args, 0, stream);
  if (e != hipSuccess) fprintf(stderr, "cooperative launch failed: %s (grid %d)\n", hipGetErrorString(e), grid_blocks);
}
```
